# Optimizing an MI355X kernel written in HIP

```python
import jax, jax.numpy as jnp
from jax import lax
import numpy as np

D_MODEL = 2048
BATCH = 4
SEQ = 8192
DEPTH = 4

GROUP_WIDTH = 128
HEAD_DIM = 128
D_GMLP = D_MODEL // 4
D_SB = D_MODEL // 4
D_MIX = D_GMLP + D_SB
N_GMLP_GROUPS = D_GMLP // GROUP_WIDTH
N_SB_HEADS = D_SB // HEAD_DIM
N_MIX_GROUPS = D_MIX // GROUP_WIDTH
D_IN = 2 * D_GMLP + 3 * D_SB
SPLIT_POINTS = (D_GMLP, 2 * D_GMLP, 2 * D_GMLP + D_SB, 2 * D_GMLP + 2 * D_SB)
CHUNK = 128
Q_BLOCK = 128
N_GROUPS = 4
EXPERTS_PER_GROUP = 8
N_EXPERTS = N_GROUPS * EXPERTS_PER_GROUP
TOP_K = 2
D_EXPERT = D_MODEL // 8
EXPERT_BLOCK = 128
N_MOD = 6
EPS = 1e-6

kernel_name = "hybrid_sgmlp_stickbreak_hmoe_adaln"


def rms_norm(x, g):
    xf = x.astype(jnp.float32)
    y = xf * lax.rsqrt(jnp.mean(xf * xf, axis=-1, keepdims=True) + EPS)
    return (y * g.astype(jnp.float32)).astype(x.dtype)


def chunked_spatial_gating(u, v, norm_g, ws, bs):
    B, S, _ = u.shape
    u = jax.nn.gelu(u, approximate=False)
    v = jax.nn.gelu(v, approximate=False).reshape(B, S // CHUNK, CHUNK, N_GMLP_GROUPS, GROUP_WIDTH)
    v = rms_norm(v, norm_g.reshape(N_GMLP_GROUPS, GROUP_WIDTH))
    w = ws * jnp.tril(jnp.ones((CHUNK, CHUNK), ws.dtype))
    s = jnp.einsum('gtp,bcpgk->bctgk', w, v) + bs.T[:, :, None]
    return u * s.reshape(B, S, D_GMLP)


def stick_breaking_attention(q, k, v):
    B, S, H, dh = q.shape
    nq = S // Q_BLOCK
    scale = HEAD_DIM ** -0.5
    qf = q.astype(jnp.float32).transpose(0, 2, 1, 3)
    kf = k.astype(jnp.float32).transpose(0, 2, 1, 3)
    vt = v.transpose(0, 2, 1, 3)
    idx = jnp.arange(Q_BLOCK, dtype=jnp.int32)
    after_in_block = (idx[:, None] > idx[None, :]).astype(jnp.float32)
    outs = []
    for n in range(nq):
        nk = n + 1
        kl = nk * Q_BLOCK
        qb = qf[:, :, n * Q_BLOCK:kl]
        z = jnp.einsum('bhqd,bhkd->bhqk', qb, kf[:, :, :kl]) * scale
        q_pos = n * Q_BLOCK + idx
        causal = jnp.arange(kl, dtype=jnp.int32)[None, :] < q_pos[:, None]
        log_fail = jnp.where(causal, jax.nn.log_sigmoid(-z), 0.0).reshape(B, H, Q_BLOCK, nk, Q_BLOCK)
        within = jnp.einsum('bhqni,ij->bhqnj', log_fail, after_in_block)
        blk = jnp.sum(log_fail, axis=-1)
        later = lax.cumsum(blk, axis=3, reverse=True) - blk
        log_a = jax.nn.log_sigmoid(z) + (within + later[..., None]).reshape(B, H, Q_BLOCK, kl)
        a = jnp.where(causal, jnp.exp(log_a), 0.0)
        outs.append(jnp.einsum('bhqk,bhkd->bhqd', a.astype(vt.dtype), vt[:, :, :kl]))
    o = jnp.concatenate(outs, axis=2)
    return o.transpose(0, 2, 1, 3).reshape(B, S, H * dh)


def hierarchical_moe(h, w_group, b_group, w_route, b_route, w_gate, w_up, w_down):
    n, d = h.shape
    hf = h.astype(jnp.float32)
    g_logits = hf @ w_group.astype(jnp.float32) + b_group.astype(jnp.float32)
    g_prob = jax.nn.softmax(g_logits, axis=-1)
    g_idx = jnp.argmax(g_logits, axis=-1).astype(jnp.int32)
    p_group = jnp.take_along_axis(g_prob, g_idx[:, None], axis=-1)
    e_logits = (hf @ w_route.astype(jnp.float32) + b_route.astype(jnp.float32)).reshape(n, N_GROUPS, EXPERTS_PER_GROUP)
    e_logits = jnp.take_along_axis(e_logits, g_idx[:, None, None], axis=1)[:, 0]
    top_val, top_idx = lax.top_k(e_logits, TOP_K)
    weights = jax.nn.softmax(top_val, axis=-1) * p_group
    expert_id = g_idx[:, None] * EXPERTS_PER_GROUP + top_idx.astype(jnp.int32)

    a = n * TOP_K
    flat_e = expert_id.reshape(a)
    flat_tok = jnp.repeat(jnp.arange(n, dtype=jnp.int32), TOP_K)
    order = jnp.argsort(flat_e)
    sorted_e = flat_e[order]
    counts = jnp.bincount(flat_e, length=N_EXPERTS).astype(jnp.int32)
    start = jnp.cumsum(counts) - counts
    padded = (counts + EXPERT_BLOCK - 1) // EXPERT_BLOCK * EXPERT_BLOCK
    pend = jnp.cumsum(padded)
    pstart = pend - padded
    rank = jnp.arange(a, dtype=jnp.int32) - start[sorted_e]
    slot = jnp.zeros((a,), jnp.int32).at[order].set((pstart[sorted_e] + rank).astype(jnp.int32))
    n_blocks = (a + EXPERT_BLOCK - 1) // EXPERT_BLOCK + N_EXPERTS
    capacity = n_blocks * EXPERT_BLOCK
    slot_tok = jnp.full((capacity,), n, jnp.int32).at[slot].set(flat_tok)
    block_e = jnp.minimum(
        jnp.searchsorted(pend, jnp.arange(n_blocks, dtype=jnp.int32) * EXPERT_BLOCK, side='right'),
        N_EXPERTS - 1).astype(jnp.int32)
    h_pad = jnp.concatenate([h, jnp.zeros((1, d), h.dtype)], axis=0)
    xs = h_pad[slot_tok].reshape(n_blocks, EXPERT_BLOCK, d)

    def expert_block(args):
        xb, e = args
        act = jax.nn.silu(xb @ w_gate[e]) * (xb @ w_up[e])
        return act @ w_down[e]

    ys = lax.map(expert_block, (xs, block_e)).reshape(capacity, d)
    picked = ys[slot].reshape(n, TOP_K, d)
    return jnp.einsum('nkd,nk->nd', picked, weights.astype(picked.dtype))


def setup_inputs(seed: int = 0) -> dict:
    key = jax.random.key(seed)
    ks = jax.random.split(key, 22)
    f32 = jnp.float32
    L, D = DEPTH, D_MODEL

    def nrm(k, shape, s):
        return jax.random.normal(k, shape, f32) * s

    return {
        "x": nrm(ks[0], (BATCH, SEQ, D), 1.0),
        "c": nrm(ks[1], (BATCH, D), 1.0),
        "w_mod": nrm(ks[2], (D, N_MOD * D), 0.5 * D ** -0.5),
        "b_mod": nrm(ks[3], (N_MOD * D,), 0.02),
        "mod_layer": nrm(ks[4], (L, N_MOD * D), 0.1),
        "norm1_g": 1.0 + nrm(ks[5], (L, D), 0.02),
        "w_in": nrm(ks[6], (L, D, D_IN), D ** -0.5),
        "gm_norm_g": 1.0 + nrm(ks[7], (L, D_GMLP), 0.02),
        "gm_ws": nrm(ks[8], (L, N_GMLP_GROUPS, CHUNK, CHUNK), CHUNK ** -0.5),
        "gm_bs": 1.0 + nrm(ks[9], (L, N_GMLP_GROUPS, CHUNK), 0.1),
        "q_norm_g": 1.0 + nrm(ks[10], (L, HEAD_DIM), 0.02),
        "k_norm_g": 1.0 + nrm(ks[11], (L, HEAD_DIM), 0.02),
        "out_norm_g": 1.0 + nrm(ks[12], (L, D_MIX), 0.02),
        "w_out": nrm(ks[13], (L, D_MIX, D), D_MIX ** -0.5),
        "norm2_g": 1.0 + nrm(ks[14], (L, D), 0.02),
        "w_group": nrm(ks[15], (L, D, N_GROUPS), D ** -0.5),
        "b_group": nrm(ks[16], (L, N_GROUPS), 0.01),
        "w_route": nrm(ks[17], (L, D, N_EXPERTS), D ** -0.5),
        "b_route": nrm(ks[18], (L, N_EXPERTS), 0.01),
        "w_gate": nrm(ks[19], (L, N_EXPERTS, D, D_EXPERT), D ** -0.5),
        "w_up": nrm(ks[20], (L, N_EXPERTS, D, D_EXPERT), D ** -0.5),
        "w_down": nrm(ks[21], (L, N_EXPERTS, D_EXPERT, D), D_EXPERT ** -0.5),
    }


def reference(x, c, w_mod, b_mod, mod_layer, norm1_g, w_in, gm_norm_g, gm_ws, gm_bs,
              q_norm_g, k_norm_g, out_norm_g, w_out, norm2_g, w_group, b_group,
              w_route, b_route, w_gate, w_up, w_down):
    B, S, D = x.shape
    mod_shared = jax.nn.silu(c) @ w_mod + b_mod
    for l in range(DEPTH):
        mod = (mod_shared + mod_layer[l])[:, None, :]
        shift1, scale1, gate1, shift2, scale2, gate2 = jnp.split(mod, N_MOD, axis=-1)

        h = rms_norm(x, norm1_g[l]) * (1.0 + scale1) + shift1
        proj = h @ w_in[l]
        u_a, v_a, q, k, v = jnp.split(proj, SPLIT_POINTS, axis=-1)
        y_a = chunked_spatial_gating(u_a, v_a, gm_norm_g[l], gm_ws[l], gm_bs[l])
        q = rms_norm(q.reshape(B, S, N_SB_HEADS, HEAD_DIM), q_norm_g[l])
        k = rms_norm(k.reshape(B, S, N_SB_HEADS, HEAD_DIM), k_norm_g[l])
        v = v.reshape(B, S, N_SB_HEADS, HEAD_DIM)
        y_b = stick_breaking_attention(q, k, v)
        y = jnp.concatenate([y_a, y_b], axis=-1).reshape(B, S, N_MIX_GROUPS, GROUP_WIDTH)
        y = rms_norm(y, out_norm_g[l].reshape(N_MIX_GROUPS, GROUP_WIDTH)).reshape(B, S, D_MIX)
        x = x + gate1 * (y @ w_out[l])

        h = rms_norm(x, norm2_g[l]) * (1.0 + scale2) + shift2
        m = hierarchical_moe(h.reshape(B * S, D), w_group[l], b_group[l], w_route[l], b_route[l],
                             w_gate[l], w_up[l], w_down[l]).reshape(B, S, D)
        x = x + gate2 * m
    return x
```

```cpp
#include <hip/hip_runtime.h>
#include <cstdio>
#include <cstdint>

#ifndef MK_ONE_LAUNCH
#define MK_ONE_LAUNCH 1
#endif

#define LAS __attribute__((address_space(3)))
#define GAS __attribute__((address_space(1)))
typedef unsigned short bf16_t;
typedef short bf16x8 __attribute__((ext_vector_type(8)));
typedef float f32x4 __attribute__((ext_vector_type(4)));
typedef float f32x2 __attribute__((ext_vector_type(2)));
typedef unsigned u32x4 __attribute__((ext_vector_type(4)));
typedef unsigned u32x2 __attribute__((ext_vector_type(2)));
typedef __bf16 bf16x2_t __attribute__((ext_vector_type(2)));

constexpr int DM = 2048, NB = 4, SEQ = 8192, NL = 4, NT = NB * SEQ;
constexpr int DIN = 2560, DMIX = 1024, NE = 32, DE = 256, NMOD = 6 * DM;
constexpr int SLOT_TILES = NT * 2 / 256 + NE, NSLOT = SLOT_TILES * 256;
constexpr float EPS = 1e-6f;
constexpr int NPHASE = 31;

constexpr size_t MiB = 1u << 20;
constexpr size_t WS_CTL = 0, CTL_ZERO_BYTES = 1 * MiB;
constexpr size_t WS_MODPART = 1 * MiB;
constexpr size_t WS_MODV = 2 * MiB;
constexpr size_t WS_TOK = 3 * MiB;
constexpr size_t WS_LIST = 4 * MiB;
constexpr size_t WS_KSQ = 8 * MiB;
constexpr size_t WS_WINT = 12 * MiB;
constexpr size_t WS_WOUTT = 52 * MiB;
constexpr size_t WS_WGUT = 68 * MiB;
constexpr size_t WS_WDT = 324 * MiB;
constexpr size_t WS_H = 452 * MiB;
constexpr size_t WS_PROJ = 580 * MiB;
constexpr size_t WS_YMIX = 740 * MiB;
constexpr size_t WS_ACT = 804 * MiB;
constexpr size_t WS_YSLOT = 840 * MiB;
constexpr size_t WS_END = 1128 * MiB;
static_assert(WS_ACT + (size_t)NSLOT * 256 * 2 <= WS_YSLOT && WS_YSLOT + (size_t)NSLOT * 2048 * 2 <= WS_END, "ws map");
constexpr int CW_BAR = 4096;
constexpr int CW_CNT = 16384;

constexpr int LDS_BYTES = 147456;
constexpr int TILE_E_OFF = 131072;
constexpr int OFFN_OFF = 133120;
constexpr int MISC_OFF = 147456 - 1024;

#define RLX_AGENT __ATOMIC_RELAXED, __HIP_MEMORY_SCOPE_AGENT
__device__ __forceinline__ unsigned f2bf(float f) { unsigned u = __builtin_bit_cast(unsigned, f); return (u + 0x7fffu + ((u >> 16) & 1u)) >> 16; }
__device__ __forceinline__ unsigned pk2(float lo, float hi) { f32x2 v = {lo, hi}; bf16x2_t b = __builtin_convertvector(v, bf16x2_t); return __builtin_bit_cast(unsigned, b); }
__device__ __forceinline__ float bflo(unsigned u) { return __builtin_bit_cast(float, u << 16); }
__device__ __forceinline__ float bfhi(unsigned u) { return __builtin_bit_cast(float, u & 0xffff0000u); }
__device__ __forceinline__ float wave_sum(float v) {
#pragma unroll
    for (int o = 1; o < 64; o <<= 1) v += __shfl_xor(v, o);
    return v;
}
__device__ __forceinline__ int fresh_tid() { int t = threadIdx.x; asm volatile("" : "+v"(t)); return t; }
__device__ __forceinline__ float gelu_exact(float x) { return 0.5f * x * (1.f + erff(x * 0.70710678118654752f)); }
__device__ __forceinline__ float silu_f(float x) { return x / (1.f + __expf(-x)); }

#define XB_TMO      128
#define XB_XCNT(j)  (256  + 64 * (j))
#define XB_XSUB(j)  (1280 + 64 * (j))
#define XB_XGEN(j)  (2304 + 64 * (j))
#define XB_TOP      3328
#define XB_TOPGEN   3392
#define XCD_BAR_WORDS 3456
#define XB_SPIN_CAP (1u << 22)
__device__ __forceinline__ unsigned xb_ld(unsigned* p)              { return __hip_atomic_load(p, __ATOMIC_RELAXED, __HIP_MEMORY_SCOPE_AGENT); }
__device__ __forceinline__ unsigned xb_add(unsigned* p, unsigned v) { return __hip_atomic_fetch_add(p, v, __ATOMIC_RELAXED, __HIP_MEMORY_SCOPE_AGENT); }
__device__ __forceinline__ unsigned xb_xcc_id() { return (unsigned)__builtin_amdgcn_s_getreg((3 << 11) | 20) & 0xFu; }
#define XB_SPIN(cond, bar) do { unsigned _sp = 0; while (cond) { __builtin_amdgcn_s_sleep(1); \
    if ((++_sp & 255u) == 0u) { if (xb_ld(&(bar)[XB_TMO])) break; if (_sp > XB_SPIN_CAP) { atomicAdd(&(bar)[XB_TMO], 1u); break; } } } } while (0)
struct XcdBarrier { unsigned* bar; unsigned x; volatile LAS unsigned* st; };
__device__ __forceinline__ XcdBarrier xcd_barrier_post(unsigned* bar, volatile LAS unsigned* st) {
    XcdBarrier b; b.bar = bar; b.x = xb_xcc_id(); b.st = st;
    if (threadIdx.x == 0) (void)xb_add(&bar[XB_XCNT(b.x)], 1u);
    return b;
}
__device__ __forceinline__ void xcd_barrier_complete(unsigned* bar, unsigned x, unsigned& nloc, unsigned& nx) {
    const unsigned G = gridDim.x * gridDim.y * gridDim.z;
    unsigned sum, cnt, mine, sp = 0u;
    for (;;) {
        sum = 0u; cnt = 0u; mine = 0u;
#pragma unroll
        for (unsigned j = 0; j < 16; ++j) { const unsigned c = xb_ld(&bar[XB_XCNT(j)]); sum += c; cnt += (c > 0u) ? 1u : 0u; mine = (j == x) ? c : mine; }
        if (sum == G) break;
        __builtin_amdgcn_s_sleep(1);
        if ((++sp & 255u) == 0u) { if (xb_ld(&bar[XB_TMO])) break; if (sp > XB_SPIN_CAP) { atomicAdd(&bar[XB_TMO], 1u); break; } }
    }
    nloc = mine > 0u ? mine : 1u; nx = cnt > 0u ? cnt : 1u;
}
__device__ __forceinline__ void xcd_barrier(const XcdBarrier& b) {
    asm volatile("s_waitcnt vmcnt(0)" ::: "memory");
    __syncthreads();
    if (threadIdx.x == 0) {
        unsigned* bar = b.bar;
        __builtin_amdgcn_s_waitcnt(0);
        unsigned nloc = b.st[0], nx = b.st[1];
        if (nloc == 0u) { xcd_barrier_complete(bar, b.x, nloc, nx); b.st[0] = nloc; b.st[1] = nx; }
        const unsigned old = xb_add(&bar[XB_XSUB(b.x)], 1u);
        const unsigned gen = old / nloc;
        if (old + 1u == (gen + 1u) * nloc) {
            __builtin_amdgcn_fence(__ATOMIC_RELEASE, "agent");
            asm volatile("s_waitcnt vmcnt(0)" ::: "memory");
            const unsigned og = xb_add(&bar[XB_TOP], 1u);
            const unsigned tg = og / nx;
            if (og + 1u == (tg + 1u) * nx) xb_add(&bar[XB_TOPGEN], 1u);
            else XB_SPIN(xb_ld(&bar[XB_TOPGEN]) == tg, bar);
            __builtin_amdgcn_fence(__ATOMIC_ACQUIRE, "agent");
            xb_add(&bar[XB_XGEN(b.x)], 1u);
            asm volatile("s_waitcnt vmcnt(0)" ::: "memory");
        } else {
            XB_SPIN(xb_ld(&bar[XB_XGEN(b.x)]) == gen, bar);
            __builtin_amdgcn_fence(__ATOMIC_ACQUIRE, "agent");
            asm volatile("s_waitcnt vmcnt(0)" ::: "memory");
        }
    }
    __syncthreads();
}

namespace pg8 {
constexpr int BM = 256, BK = 64, HALF = 128, HTB = HALF * BK * 2, NXCD = 8, WGM = 8;
__device__ __forceinline__ int lds_byte(int r, int c) { const int st = (r >> 4) * 2 + (c >> 5), rr = r & 15, cc = c & 31, ob = rr * 64 + cc * 2; return st * 1024 + (ob ^ (((ob >> 9) & 1) << 5)); }
__device__ __forceinline__ void stage_rc(int b, int& R, int& C) { const int st = b / 1024, sb = b % 1024, swz = sb ^ (((sb >> 9) & 1) << 5); R = (st >> 1) * 16 + swz / 64; C = (st & 1) * 32 + (swz % 64) / 2; }
__device__ __forceinline__ int perm32(int rho) { const int n = rho >> 4, i = rho & 15; return 8 * (i >> 2) + 4 * n + (i & 3); }

template <class Epi, class Sched>
__device__ __forceinline__ void gemm_phase(LAS unsigned char* lds, const bf16_t* Abase, const int K, const Sched& S, const Epi& E) {
    typedef typename Sched::Unit Unit;
    constexpr bool GATHER = Sched::GATHER;
    const int tid = fresh_tid(), wid = __builtin_amdgcn_readfirstlane(tid >> 6), lane = tid & 63, wr = wid >> 2, wc = wid & 3, fr = lane & 15, fq = lane >> 4;
    const int nt = K / BK;
    unsigned voffA[2], voffB[2];
#pragma unroll
    for (int i = 0; i < 2; ++i) { int R, C; stage_rc(tid * 16 + i * 8192, R, C); const int Rb = Epi::PERM ? ((R & ~31) + perm32(R & 31)) : R;
        voffA[i] = (unsigned)(R * K + C) * 2u; voffB[i] = (unsigned)(Rb * K + C) * 2u; }
    const size_t kstep = (size_t)(BK * 2);
    const size_t hstep = (size_t)HALF * K * 2;
    const unsigned ldsw = (unsigned)wid * 1024u;
    const int aoff = lds_byte(wr * 64 + fr, fq * 8), boff = lds_byte(wc * 32 + fr, fq * 8);
    const char* Ab = (const char*)Abase;
#define PG8_SA(b, h) (((b) * 2 + (h)) * HTB)
#define PG8_SB(b, h) ((4 + (b) * 2 + (h)) * HTB)
#define PG8_STAGE(bufoff, gbase, voff) do { _Pragma("unroll") for (int _i = 0; _i < 2; ++_i) \
        __builtin_amdgcn_global_load_lds((const unsigned*)((const char*)(gbase) + (voff)[_i]), (LAS unsigned*)(lds + (bufoff) + ldsw + _i * 8192), 16, 0, 0); } while (0)
#define PG8_STAGEA(bufoff, p, kb, off, h) do { if constexpr (GATHER) { PG8_STAGE(bufoff, Ab + (kb), (off) + 2 * (h)); } else { PG8_STAGE(bufoff, (p) + (h) * hstep, voffA); } } while (0)
#define PG8_LDA(dst, b, h) do { _Pragma("unroll") for (int m = 0; m < 4; ++m) _Pragma("unroll") for (int k = 0; k < 2; ++k) dst[m][k] = *(const LAS bf16x8*)(lds + PG8_SA(b, h) + aoff + m * 2048 + k * 1024); } while (0)
#define PG8_LDB(dst, b, h) do { _Pragma("unroll") for (int n = 0; n < 2; ++n) _Pragma("unroll") for (int k = 0; k < 2; ++k) dst[n][k] = *(const LAS bf16x8*)(lds + PG8_SB(b, h) + boff + n * 2048 + k * 1024); } while (0)
#define PG8_MMA(ai, bj, At, Bt) do { __builtin_amdgcn_s_setprio(1); _Pragma("unroll") for (int m = 0; m < 4; ++m) _Pragma("unroll") for (int n = 0; n < 2; ++n) _Pragma("unroll") for (int k = 0; k < 2; ++k) \
        acc[ai][bj][m][n] = __builtin_amdgcn_mfma_f32_16x16x32_bf16(Bt[n][k], At[m][k], acc[ai][bj][m][n], 0, 0, 0); __builtin_amdgcn_s_setprio(0); } while (0)
#define PG8_WAIT_V(n) asm volatile("s_waitcnt vmcnt(" #n ")" ::: "memory")
#define PG8_WAIT_L(n) asm volatile("s_waitcnt lgkmcnt(" #n ")" ::: "memory")
#define PG8_BAR __builtin_amdgcn_s_barrier()
#define PG8_SCHED __builtin_amdgcn_sched_barrier(0)
#define PG8_AOFF(u, dst) do { _Pragma("unroll") for (int _h = 0; _h < 2; ++_h) _Pragma("unroll") for (int _i = 0; _i < 2; ++_i) { \
        int _R, _C; stage_rc(tid * 16 + _i * 8192, _R, _C); dst[_h * 2 + _i] = (S.arow(u, _h * HALF + _R) * (unsigned)K + (unsigned)_C) * 2u; } } while (0)
    Unit cur, nxt; int ui = 0;
    if (!S.next(0, cur)) return;
    f32x4 acc[2][2][4][2];
#pragma unroll
    for (int a = 0; a < 2; ++a)
#pragma unroll
        for (int b = 0; b < 2; ++b)
#pragma unroll
            for (int m = 0; m < 4; ++m)
#pragma unroll
                for (int n = 0; n < 2; ++n) acc[a][b][m][n] = (f32x4){0.f, 0.f, 0.f, 0.f};
    bf16x8 At[4][2], B0[2][2], B1[2][2];
    unsigned offc[4] = {0u, 0u, 0u, 0u}, offn[4] = {0u, 0u, 0u, 0u};
    volatile LAS unsigned* onx = (volatile LAS unsigned*)(lds + OFFN_OFF) + tid * 4;
    if constexpr (GATHER) PG8_AOFF(cur, offc);
    const char* cA = GATHER ? Ab : S.aptr(cur, Ab);
    const char* cB = S.bptr(cur);
    PG8_STAGE(PG8_SB(0, 0), cB, voffB); PG8_STAGE(PG8_SB(0, 1), cB + hstep, voffB); PG8_STAGEA(PG8_SA(0, 0), cA, 0, offc, 0); PG8_STAGEA(PG8_SA(0, 1), cA, 0, offc, 1);
    if (wr == 1) PG8_BAR;
    PG8_WAIT_V(2); PG8_BAR;
    PG8_STAGE(PG8_SB(1, 0), cB + kstep, voffB); PG8_STAGEA(PG8_SA(1, 0), cA + kstep, kstep, offc, 0); PG8_STAGE(PG8_SB(1, 1), cB + hstep + kstep, voffB);
    PG8_WAIT_V(6); PG8_BAR;
    for (;;) {
        const bool has_next = S.next(ui + 1, nxt);
        const char* nA = cA; const char* nB = cB;
        if (has_next) { nB = S.bptr(nxt); if constexpr (!GATHER) nA = S.aptr(nxt, Ab);
            if constexpr (GATHER) { unsigned tmp[4]; PG8_AOFF(nxt, tmp);
#pragma unroll
                for (int j = 0; j < 4; ++j) onx[j] = tmp[j]; } }
#pragma unroll 1
        for (int t = 0; t < nt; t += 2) {
            const bool last = (t == nt - 2);
            const char* a1 = cA + (size_t)(t + 1) * kstep; const size_t k1 = (size_t)(t + 1) * kstep;
            const char* a2 = last ? nA : cA + (size_t)(t + 2) * kstep; const size_t k2 = last ? 0 : (size_t)(t + 2) * kstep;
            const char* b2 = last ? nB : cB + (size_t)(t + 2) * kstep;
            const char* a3 = a2 + kstep; const char* b3 = b2 + kstep; const size_t k3 = k2 + kstep;
            if constexpr (GATHER) {
#pragma unroll
                for (int j = 0; j < 4; ++j) offn[j] = offc[j];
                if (last && has_next) {
#pragma unroll
                    for (int j = 0; j < 4; ++j) offn[j] = onx[j];
                }
            }
            PG8_LDB(B0, 0, 0); PG8_LDB(B1, 0, 1); PG8_SCHED; PG8_LDA(At, 0, 0); PG8_STAGEA(PG8_SA(1, 1), a1, k1, offc, 1);
            PG8_WAIT_V(8); PG8_WAIT_L(0); PG8_BAR; PG8_MMA(0, 0, At, B0); PG8_MMA(0, 1, At, B1); PG8_BAR; PG8_SCHED;
            PG8_LDA(At, 0, 1); PG8_STAGE(PG8_SB(0, 0), b2, voffB); PG8_STAGE(PG8_SB(0, 1), b2 + hstep, voffB); PG8_STAGEA(PG8_SA(0, 0), a2, k2, offn, 0);
            PG8_WAIT_V(8); PG8_WAIT_L(0); PG8_BAR; PG8_MMA(1, 0, At, B0); PG8_MMA(1, 1, At, B1); PG8_BAR; PG8_SCHED;
            PG8_LDB(B0, 1, 0); PG8_LDB(B1, 1, 1); PG8_SCHED; PG8_LDA(At, 1, 0); PG8_STAGEA(PG8_SA(0, 1), a2, k2, offn, 1);
            PG8_WAIT_V(8); PG8_WAIT_L(0); PG8_BAR; PG8_MMA(0, 0, At, B0); PG8_MMA(0, 1, At, B1); PG8_BAR; PG8_SCHED;
            PG8_LDA(At, 1, 1); PG8_STAGE(PG8_SB(1, 0), b3, voffB); PG8_STAGE(PG8_SB(1, 1), b3 + hstep, voffB); PG8_STAGEA(PG8_SA(1, 0), a3, k3, offn, 0);
            PG8_WAIT_V(8); PG8_WAIT_L(0); PG8_BAR; PG8_MMA(1, 0, At, B0); PG8_MMA(1, 1, At, B1); PG8_BAR; PG8_SCHED;
        }
        if (wr == 0) PG8_BAR;
        E(acc, cur, wr, wc, fr, fq);
        if (!has_next) break;
#pragma unroll
        for (int a = 0; a < 2; ++a)
#pragma unroll
            for (int b = 0; b < 2; ++b)
#pragma unroll
                for (int m = 0; m < 4; ++m)
#pragma unroll
                    for (int n = 0; n < 2; ++n) acc[a][b][m][n] = (f32x4){0.f, 0.f, 0.f, 0.f};
        cur = nxt; cA = nA; cB = nB; ++ui;
        if constexpr (GATHER) {
#pragma unroll
            for (int j = 0; j < 4; ++j) offc[j] = onx[j];
        }
        if (wr == 1) PG8_BAR;
    }
    PG8_WAIT_V(0);
    PG8_BAR;
#undef PG8_SA
#undef PG8_SB
#undef PG8_STAGE
#undef PG8_STAGEA
#undef PG8_LDA
#undef PG8_LDB
#undef PG8_MMA
#undef PG8_WAIT_V
#undef PG8_WAIT_L
#undef PG8_BAR
#undef PG8_SCHED
#undef PG8_AOFF
}
}

struct DenseUnit { int pm, pn; };
struct DenseSched {
    typedef DenseUnit Unit;
    int nM, nN, nwg, G, c; const bf16_t* Bt; int K;
    __device__ __forceinline__ void init(int M, int N, int K_, const bf16_t* Bt_, int G_, int c_) { nM = M / 256; nN = N / 256; nwg = nM * nN; G = G_; c = c_; Bt = Bt_; K = K_; }
    __device__ __forceinline__ bool next(int i, Unit& u) const {
        const long L = (long)i * G + c; if (L >= nwg) return false;
        int wgid = (int)L; { const int q = nwg / 8, r = nwg % 8, xcd = wgid % 8, off = wgid / 8; wgid = (xcd < r ? xcd * (q + 1) : r * (q + 1) + (xcd - r) * q) + off; }
        const int nig = 8 * nN, gid = wgid / nig, fm = gid * 8, gsz = (nM - fm) < 8 ? (nM - fm) : 8;
        u.pm = fm + ((wgid % nig) % gsz); u.pn = (wgid % nig) / gsz; return true;
    }
    static constexpr bool GATHER = false;
    __device__ __forceinline__ unsigned arow(const Unit& u, int r) const { return (unsigned)(u.pm * 256 + r); }
    __device__ __forceinline__ const char* aptr(const Unit& u, const char* Ab) const { return Ab + (size_t)u.pm * 256 * K * 2; }
    __device__ __forceinline__ const char* bptr(const Unit& u) const { return (const char*)(Bt + (size_t)u.pn * 256 * K); }
};
struct MoeUnit { int e, tile, rt, pn, cnt; };
template <bool GATHER_>
struct MoeSched {
    typedef MoeUnit Unit;
    static constexpr bool GATHER = GATHER_;
    const volatile LAS unsigned* tp;
    const volatile LAS unsigned* cnt;
    const volatile LAS unsigned* te;
    const int* list;
    const bf16_t* Bt; size_t bstride_e; int K; int npn, lognpn; int G, c;
    __device__ __forceinline__ bool next(int i, Unit& u) const {
        const int L = i * G + c; const int tile = L >> lognpn; const int ntile = __builtin_amdgcn_readfirstlane((int)tp[32]);
        if (tile >= ntile) return false;
        u.e = __builtin_amdgcn_readfirstlane((int)te[tile]); u.tile = tile; u.rt = tile - __builtin_amdgcn_readfirstlane((int)tp[u.e]);
        u.cnt = __builtin_amdgcn_readfirstlane((int)cnt[u.e]); u.pn = L & (npn - 1); return true;
    }
    __device__ __forceinline__ const char* aptr(const Unit& u, const char* Ab) const { return Ab + (size_t)u.tile * 256 * K * 2; }
    __device__ __forceinline__ unsigned arow(const Unit& u, int r) const {
        const int slot = u.rt * 256 + r;
        return (slot < u.cnt) ? (unsigned)list[(size_t)u.e * NT + slot] : 0u;
    }
    __device__ __forceinline__ const char* bptr(const Unit& u) const { return (const char*)(Bt + (size_t)u.e * bstride_e + (size_t)u.pn * 256 * K); }
};

struct EpiProj {
    static constexpr bool PERM = true;
    bf16_t* O; float* ksq;
    __device__ __forceinline__ void operator()(const f32x4 (&acc)[2][2][4][2], const DenseUnit& u, int wr, int wc, int fr, int fq) const {
        const int row0 = u.pm * 256 + wr * 64 + fr, col0 = u.pn * 256 + wc * 32 + 8 * fq;
        const bool qk = (u.pn >= 4 && u.pn < 8);
#pragma unroll
        for (int ai = 0; ai < 2; ++ai)
#pragma unroll
            for (int m = 0; m < 4; ++m) { const int row = row0 + ai * 128 + m * 16; bf16_t* rowp = O + (size_t)row * DIN + col0;
#pragma unroll
                for (int bj = 0; bj < 2; ++bj) { const f32x4 v0 = acc[ai][bj][m][0], v1 = acc[ai][bj][m][1];
                    u32x4 w; w.x = pk2(v0[0], v0[1]); w.y = pk2(v0[2], v0[3]); w.z = pk2(v1[0], v1[1]); w.w = pk2(v1[2], v1[3]);
                    *(u32x4*)(rowp + bj * 128) = w;
                    if (qk) { float ss = (v0[0] * v0[0] + v0[1] * v0[1]) + (v0[2] * v0[2] + v0[3] * v0[3]) + (v1[0] * v1[0] + v1[1] * v1[1]) + (v1[2] * v1[2] + v1[3] * v1[3]);
                        ss += __shfl_xor(ss, 16); ss += __shfl_xor(ss, 32);
                        if (fq == 0) ksq[((size_t)row * 8 + (u.pn - 4) * 2 + bj) * 4 + wc] = ss; } } }
    }
};
struct EpiOut {
    static constexpr bool PERM = false;
    float* X; const float* gate;
    __device__ __forceinline__ void operator()(const f32x4 (&acc)[2][2][4][2], const DenseUnit& u, int wr, int wc, int fr, int fq) const {
        const int row0 = u.pm * 256 + wr * 64 + fr, col0 = u.pn * 256 + wc * 32 + 4 * fq;
        const int b = (u.pm * 256) / SEQ;
        f32x4 gv[2][2];
#pragma unroll
        for (int bj = 0; bj < 2; ++bj)
#pragma unroll
            for (int n = 0; n < 2; ++n) gv[bj][n] = *(const f32x4*)(gate + (size_t)b * 6 * DM + col0 + bj * 128 + n * 16);
#pragma unroll
        for (int ai = 0; ai < 2; ++ai)
#pragma unroll
            for (int m = 0; m < 4; ++m) { float* rowp = X + (size_t)(row0 + ai * 128 + m * 16) * DM + col0;
#pragma unroll
                for (int bj = 0; bj < 2; ++bj)
#pragma unroll
                    for (int n = 0; n < 2; ++n) { f32x4* p = (f32x4*)(rowp + bj * 128 + n * 16); *p = *p + gv[bj][n] * acc[ai][bj][m][n]; }
                asm volatile("" ::: "memory"); }
    }
};
struct EpiAct {
    static constexpr bool PERM = true;
    bf16_t* O;
    __device__ __forceinline__ void operator()(const f32x4 (&acc)[2][2][4][2], const MoeUnit& u, int wr, int wc, int fr, int fq) const {
        const int row0 = u.tile * 256 + wr * 64 + fr, col0 = u.pn * 128 + wc * 32 + 8 * fq;
#pragma unroll
        for (int ai = 0; ai < 2; ++ai)
#pragma unroll
            for (int m = 0; m < 4; ++m) { bf16_t* rowp = O + (size_t)(row0 + ai * 128 + m * 16) * DE + col0;
                float r[8];
#pragma unroll
                for (int n = 0; n < 2; ++n)
#pragma unroll
                    for (int j = 0; j < 4; ++j) r[n * 4 + j] = silu_f(acc[ai][0][m][n][j]) * acc[ai][1][m][n][j];
                u32x4 w; w.x = pk2(r[0], r[1]); w.y = pk2(r[2], r[3]); w.z = pk2(r[4], r[5]); w.w = pk2(r[6], r[7]);
                *(u32x4*)rowp = w; }
    }
};
struct EpiY {
    static constexpr bool PERM = true;
    bf16_t* O;
    __device__ __forceinline__ void operator()(const f32x4 (&acc)[2][2][4][2], const MoeUnit& u, int wr, int wc, int fr, int fq) const {
        const int row0 = u.tile * 256 + wr * 64 + fr, col0 = u.pn * 256 + wc * 32 + 8 * fq;
#pragma unroll
        for (int ai = 0; ai < 2; ++ai)
#pragma unroll
            for (int m = 0; m < 4; ++m) { bf16_t* rowp = O + (size_t)(row0 + ai * 128 + m * 16) * DM + col0;
#pragma unroll
                for (int bj = 0; bj < 2; ++bj) { const f32x4 v0 = acc[ai][bj][m][0], v1 = acc[ai][bj][m][1];
                    u32x4 w; w.x = pk2(v0[0], v0[1]); w.y = pk2(v0[2], v0[3]); w.z = pk2(v1[0], v1[1]); w.w = pk2(v1[2], v1[3]);
                    *(u32x4*)(rowp + bj * 128) = w; } }
    }
};

struct Args { const float* in[22]; float* out; unsigned char* ws; int ph_lo, ph_hi; };
struct Frame {
    LAS unsigned char* lds; volatile LAS unsigned* MISC; unsigned* ctl;
    int tid, lane, wave, vcu, G, gw, NGW;
};

typedef const __attribute__((address_space(4))) Args CArgs;
struct ArgV { CArgs* p;
    __device__ __forceinline__ const float* in(int i) const { return p->in[i]; }
    __device__ __forceinline__ unsigned char* ws() const { return p->ws; }
    __device__ __forceinline__ float* out() const { return p->out; }
    __device__ __forceinline__ int ph_lo() const { return p->ph_lo; }
    __device__ __forceinline__ int ph_hi() const { return p->ph_hi; } };
__device__ __forceinline__ ArgV get_args() { CArgs* p = (CArgs*)__builtin_amdgcn_kernarg_segment_ptr(); asm volatile("" : "+s"(p)); ArgV a; a.p = p; return a; }
__device__ __forceinline__ void transpose_item(const float* src, int N, int k0, int n0, bf16_t* dst, int Kd, int drow0, LAS float* scr, int lane) {
#pragma unroll 4
    for (int i = 0; i < 16; ++i) { const int kk = 4 * i + (lane >> 4), c4 = (lane & 15) * 4;
        const f32x4 v = *(const f32x4*)(src + (size_t)(k0 + kk) * N + n0 + c4);
        LAS float* s = scr + kk * 65 + c4; s[0] = v[0]; s[1] = v[1]; s[2] = v[2]; s[3] = v[3]; }
    asm volatile("s_waitcnt lgkmcnt(0)" ::: "memory");
#pragma unroll 2
    for (int i = 0; i < 8; ++i) { const int cid = lane + 64 * i, n = cid >> 3, c = cid & 7; const LAS float* s = scr + (8 * c) * 65 + n;
        u32x4 o; o.x = pk2(s[0 * 65], s[1 * 65]); o.y = pk2(s[2 * 65], s[3 * 65]); o.z = pk2(s[4 * 65], s[5 * 65]); o.w = pk2(s[6 * 65], s[7 * 65]);
        *(u32x4*)(dst + (size_t)(drow0 + n) * Kd + k0 + 8 * c) = o; }
    asm volatile("s_waitcnt lgkmcnt(0)" ::: "memory");
}

__device__ __forceinline__ void phase_modpart(Frame& F, const float* c, const float* w_mod, float* modpart) {
    const int tid_ = fresh_tid(), lane_ = tid_ & 63; (void)tid_; (void)lane_;
    LAS float* red = (LAS float*)F.lds;
    for (int item = F.vcu; item < 256; item += F.G) {
        const int cg = item & 63, ks = item >> 6;
        const int cq = tid_ % 48, rg = tid_ / 48;
        float a[4][4];
#pragma unroll
        for (int b = 0; b < 4; ++b)
#pragma unroll
            for (int j = 0; j < 4; ++j) a[b][j] = 0.f;
        if (rg < 10) {
            for (int k = ks * 512 + rg; k < ks * 512 + 512; k += 10) {
                const f32x4 w = *(const f32x4*)(w_mod + (size_t)k * NMOD + cg * 192 + cq * 4);
#pragma unroll
                for (int b = 0; b < 4; ++b) { const float s = silu_f(c[b * DM + k]);
#pragma unroll
                    for (int j = 0; j < 4; ++j) a[b][j] += s * w[j]; }
            }
#pragma unroll
            for (int b = 0; b < 4; ++b)
#pragma unroll
                for (int j = 0; j < 4; ++j) red[(rg * 4 + b) * 192 + cq * 4 + j] = a[b][j];
        }
        __syncthreads();
        for (int o = tid_; o < 4 * 192; o += 512) { const int b = o / 192, col = o % 192; float s = 0.f;
            for (int r = 0; r < 10; ++r) s += red[(r * 4 + b) * 192 + col];
            modpart[((size_t)ks * 4 + b) * NMOD + cg * 192 + col] = s; }
        __syncthreads();
    }
}

__device__ __forceinline__ void phase_prep(Frame& F, const ArgV A) {
    const int tid_ = fresh_tid(), lane_ = tid_ & 63; (void)tid_; (void)lane_;
    const float* modpart = (const float*)(A.ws() + WS_MODPART); float* modv = (float*)(A.ws() + WS_MODV);
    const float *b_mod = A.in(3), *mod_layer = A.in(4), *norm1_g = A.in(5), *norm2_g = A.in(14);
    for (int idx = F.vcu * 512 + tid_; idx < NL * NB * 6 * DM; idx += F.G * 512) {
        const int col = idx % DM, which = (idx / DM) % 6, b = (idx / (6 * DM)) % NB, l = idx / (6 * DM * NB);
        const int n = which * DM + col;
        float m = b_mod[n] + mod_layer[l * NMOD + n];
#pragma unroll
        for (int ks = 0; ks < 4; ++ks) m += modpart[((size_t)ks * 4 + b) * NMOD + n];
        float o = m;
        if (which == 1) o = norm1_g[l * DM + col] * (1.f + m);
        if (which == 4) o = norm2_g[l * DM + col] * (1.f + m);
        modv[idx] = o;
    }
    LAS float* scr = (LAS float*)(F.lds + F.wave * 16640);
    constexpr int I_IN = NL * 32 * 40, I_OUT = NL * 16 * 32, I_GU = NL * NE * 2 * 32 * 4, I_DN = NL * NE * 4 * 32;
    const float *w_in = A.in(6), *w_out = A.in(13), *w_gate = A.in(19), *w_up = A.in(20), *w_down = A.in(21);
    bf16_t* WinT = (bf16_t*)(A.ws() + WS_WINT); bf16_t* WoutT = (bf16_t*)(A.ws() + WS_WOUTT); bf16_t* WguT = (bf16_t*)(A.ws() + WS_WGUT); bf16_t* WdT = (bf16_t*)(A.ws() + WS_WDT);
    for (int it = F.gw; it < I_IN + I_OUT + I_GU + I_DN; it += F.NGW) {
        int r = it;
        if (r < I_IN) { const int l = r / (32 * 40), q = r % (32 * 40), kb = q / 40, nb = q % 40;
            transpose_item(w_in + (size_t)l * DM * DIN, DIN, 64 * kb, 64 * nb, WinT + (size_t)l * DIN * DM, DM, 64 * nb, scr, lane_); continue; }
        r -= I_IN;
        if (r < I_OUT) { const int l = r / (16 * 32), q = r % (16 * 32), kb = q / 32, nb = q % 32;
            transpose_item(w_out + (size_t)l * DMIX * DM, DM, 64 * kb, 64 * nb, WoutT + (size_t)l * DM * DMIX, DMIX, 64 * nb, scr, lane_); continue; }
        r -= I_OUT;
        if (r < I_GU) { const int le = r / 256, q = r % 256, up = q >> 7, kb = (q & 127) >> 2, nb = q & 3;
            const float* src = (up ? w_up : w_gate) + (size_t)le * DM * DE;
            const int n0 = 64 * nb, drow0 = 256 * (n0 >> 7) + (n0 & 127) + 128 * up;
            transpose_item(src, DE, 64 * kb, n0, WguT + (size_t)le * 512 * DM, DM, drow0, scr, lane_); continue; }
        r -= I_GU;
        { const int le = r / 128, q = r % 128, kb = q >> 5, nb = q & 31;
            transpose_item(w_down + (size_t)le * DE * DM, DM, 64 * kb, 64 * nb, WdT + (size_t)le * DM * DE, DE, 64 * nb, scr, lane_); }
    }
}

__device__ __forceinline__ void build_tiles(Frame& F, int lc) {
    const int tid_ = fresh_tid(), lane_ = tid_ & 63; (void)tid_; (void)lane_;
    __syncthreads();
    if (tid_ < 32) { const unsigned n = __hip_atomic_load(F.ctl + CW_CNT + (lc * 32 + tid_) * 64, RLX_AGENT); F.MISC[64 + tid_] = n; }
    __syncthreads();
    if (tid_ == 0) { unsigned p = 0; for (int e = 0; e < 32; ++e) { F.MISC[16 + e] = p; p += (F.MISC[64 + e] + 255u) >> 8; } F.MISC[16 + 32] = p; }
    __syncthreads();
    if (tid_ < 32) { volatile LAS unsigned* te = (volatile LAS unsigned*)(F.lds + TILE_E_OFF); const unsigned a = F.MISC[16 + tid_], b = F.MISC[17 + tid_]; for (unsigned t = a; t < b; ++t) te[t] = (unsigned)tid_; }
    __syncthreads();
}

template <bool DO_NORM>
__device__ __forceinline__ void phase_norm1(Frame& F, const ArgV A, int l, bool combine, const float* x_src, float* x_dst, bool write_x) {
    const int tid_ = fresh_tid(), lane_ = tid_ & 63; (void)tid_; (void)lane_;
    const float* modv = (const float*)(A.ws() + WS_MODV);
    const bf16_t* yslot = (const bf16_t*)(A.ws() + WS_YSLOT); bf16_t* hout = (bf16_t*)(A.ws() + WS_H);
    const int* tok = (const int*)(A.ws() + WS_TOK);
    if (combine) build_tiles(F, l - 1);
    for (int blk = F.vcu; blk < NT / 128; blk += F.G) {
        const int b = (blk * 128) / SEQ;
        const float* mA_ = modv + ((size_t)((DO_NORM ? l : 0) * NB + b) * 6 + 1) * DM;
        const float* mS_ = modv + ((size_t)((DO_NORM ? l : 0) * NB + b) * 6 + 0) * DM;
        const float* mG_ = modv + ((size_t)((combine ? l - 1 : 0) * NB + b) * 6 + 5) * DM;
#pragma unroll 1
        for (int i = 0; i < 16; ++i) {
            const int row = blk * 128 + F.wave * 16 + i;
            const float *mA = mA_, *mS = mS_, *mG = mG_;
            asm volatile("" : "+s"(mA), "+s"(mS), "+s"(mG));
            const f32x4* xr = (const f32x4*)(x_src + (size_t)row * DM) + lane_;
            f32x4 v[8];
#pragma unroll
            for (int j = 0; j < 8; ++j) v[j] = xr[64 * j];
            if (combine) {
                const int e0 = tok[row * 8 + 0], e1 = tok[row * 8 + 1], p0 = tok[row * 8 + 2], p1 = tok[row * 8 + 3];
                const float w0 = __builtin_bit_cast(float, tok[row * 8 + 4]), w1 = __builtin_bit_cast(float, tok[row * 8 + 5]);
                const size_t s0 = (size_t)F.MISC[16 + e0] * 256 + p0, s1 = (size_t)F.MISC[16 + e1] * 256 + p1;
                const u32x2* y0 = (const u32x2*)(yslot + s0 * DM) + lane_; const u32x2* y1 = (const u32x2*)(yslot + s1 * DM) + lane_;
#pragma unroll
                for (int j = 0; j < 8; ++j) { const u32x2 a = y0[64 * j], c = y1[64 * j]; const f32x4 g = *((const f32x4*)mG + lane_ + 64 * j);
                    v[j][0] += g[0] * (w0 * bflo(a.x) + w1 * bflo(c.x)); v[j][1] += g[1] * (w0 * bfhi(a.x) + w1 * bfhi(c.x));
                    v[j][2] += g[2] * (w0 * bflo(a.y) + w1 * bflo(c.y)); v[j][3] += g[3] * (w0 * bfhi(a.y) + w1 * bfhi(c.y)); }
            }
            if (write_x) { f32x4* xo = (f32x4*)(x_dst + (size_t)row * DM) + lane_;
#pragma unroll
                for (int j = 0; j < 8; ++j) xo[64 * j] = v[j]; }
            if (DO_NORM) {
                float ss = 0.f;
#pragma unroll
                for (int j = 0; j < 8; ++j) ss += (v[j][0] * v[j][0] + v[j][1] * v[j][1]) + (v[j][2] * v[j][2] + v[j][3] * v[j][3]);
                const float rstd = 1.f / sqrtf(wave_sum(ss) * (1.f / DM) + EPS);
                u32x2* ho = (u32x2*)(hout + (size_t)row * DM) + lane_;
#pragma unroll
                for (int j = 0; j < 8; ++j) { const f32x4 a = *((const f32x4*)mA + lane_ + 64 * j), s = *((const f32x4*)mS + lane_ + 64 * j);
                    u32x2 o; o.x = pk2(v[j][0] * rstd * a[0] + s[0], v[j][1] * rstd * a[1] + s[1]); o.y = pk2(v[j][2] * rstd * a[2] + s[2], v[j][3] * rstd * a[3] + s[3]);
                    ho[64 * j] = o; }
            }
        }
    }
}

__device__ __forceinline__ void phase_gmlp(Frame& F, const ArgV A, int l) {
    const int tid_ = fresh_tid(), lane_ = tid_ & 63; (void)tid_; (void)lane_;
    const bf16_t* proj = (const bf16_t*)(A.ws() + WS_PROJ); bf16_t* ymix = (bf16_t*)(A.ws() + WS_YMIX);
    const float *gm_norm_g = A.in(7) + l * 512, *gm_ws = A.in(8) + (size_t)l * 4 * 128 * 128, *gm_bs = A.in(9) + l * 512, *out_norm_g = A.in(12) + l * DMIX;
    LAS float* vn = (LAS float*)F.lds;
    for (int u = F.vcu; u < NT / 128 * 4; u += F.G) {
        const int g = u & 3, ch = u >> 2, row0 = ch * 128;
        const int p = tid_ >> 2, seg = tid_ & 3;
        {
            const u32x4* vp = (const u32x4*)(proj + (size_t)(row0 + p) * DIN + 512 + g * 128 + seg * 32);
            float x[32]; float ss = 0.f;
#pragma unroll
            for (int c = 0; c < 4; ++c) { const u32x4 w = vp[c];
                x[c * 8 + 0] = bflo(w.x); x[c * 8 + 1] = bfhi(w.x); x[c * 8 + 2] = bflo(w.y); x[c * 8 + 3] = bfhi(w.y);
                x[c * 8 + 4] = bflo(w.z); x[c * 8 + 5] = bfhi(w.z); x[c * 8 + 6] = bflo(w.w); x[c * 8 + 7] = bfhi(w.w); }
#pragma unroll
            for (int j = 0; j < 32; ++j) { x[j] = gelu_exact(x[j]); ss += x[j] * x[j]; }
            ss += __shfl_xor(ss, 1); ss += __shfl_xor(ss, 2);
            const float rv = 1.f / sqrtf(ss * (1.f / 128.f) + EPS);
#pragma unroll
            for (int j = 0; j < 32; ++j) vn[p * 132 + seg * 32 + j] = x[j] * rv * gm_norm_g[g * 128 + seg * 32 + j];
        }
        __syncthreads();
        {
            const int t = p;
            float s[32];
#pragma unroll
            for (int j = 0; j < 32; ++j) s[j] = 0.f;
            const float* wrow = gm_ws + ((size_t)g * 128 + t) * 128;
            for (int pp = 0; pp <= t; ++pp) { const float w = wrow[pp]; const LAS f32x4* vr = (const LAS f32x4*)(vn + pp * 132 + seg * 32);
#pragma unroll
                for (int c = 0; c < 8; ++c) { const f32x4 q = vr[c]; s[c * 4 + 0] += w * q[0]; s[c * 4 + 1] += w * q[1]; s[c * 4 + 2] += w * q[2]; s[c * 4 + 3] += w * q[3]; } }
            const float bias = gm_bs[g * 128 + t];
            const u32x4* up = (const u32x4*)(proj + (size_t)(row0 + t) * DIN + g * 128 + seg * 32);
            float ss = 0.f;
#pragma unroll
            for (int c = 0; c < 4; ++c) { const u32x4 w = up[c]; float uu[8] = {bflo(w.x), bfhi(w.x), bflo(w.y), bfhi(w.y), bflo(w.z), bfhi(w.z), bflo(w.w), bfhi(w.w)};
#pragma unroll
                for (int j = 0; j < 8; ++j) { const float y = gelu_exact(uu[j]) * (s[c * 8 + j] + bias); s[c * 8 + j] = y; ss += y * y; } }
            ss += __shfl_xor(ss, 1); ss += __shfl_xor(ss, 2);
            const float ry = 1.f / sqrtf(ss * (1.f / 128.f) + EPS);
            u32x4* yo = (u32x4*)(ymix + (size_t)(row0 + t) * DMIX + g * 128 + seg * 32);
            const float* og = out_norm_g + g * 128 + seg * 32;
#pragma unroll
            for (int c = 0; c < 4; ++c) { u32x4 w;
                w.x = pk2(s[c * 8 + 0] * ry * og[c * 8 + 0], s[c * 8 + 1] * ry * og[c * 8 + 1]); w.y = pk2(s[c * 8 + 2] * ry * og[c * 8 + 2], s[c * 8 + 3] * ry * og[c * 8 + 3]);
                w.z = pk2(s[c * 8 + 4] * ry * og[c * 8 + 4], s[c * 8 + 5] * ry * og[c * 8 + 5]); w.w = pk2(s[c * 8 + 6] * ry * og[c * 8 + 6], s[c * 8 + 7] * ry * og[c * 8 + 7]);
                yo[c] = w; }
        }
        __syncthreads();
    }
}

__device__ __forceinline__ void phase_attn(Frame& F, const ArgV A, int l) {
    const int tid_ = fresh_tid(), lane_ = tid_ & 63; (void)tid_; (void)lane_;
    const bf16_t* proj = (const bf16_t*)(A.ws() + WS_PROJ); bf16_t* ymix = (bf16_t*)(A.ws() + WS_YMIX); const float* ksq = (const float*)(A.ws() + WS_KSQ);
    const float *qg = A.in(10) + l * 128, *kg = A.in(11) + l * 128, *out_norm_g = A.in(12) + l * DMIX;
    LAS float* qsh = (LAS float*)(F.lds + 98304) + F.wave * 128;
    const float c2 = 1.4426950408889634f * 0.08838834764831845f;
    const int lane = lane_;
    for (int u = F.gw; u < NT * 4; u += F.NGW) {
        const int hd = u & 3, rowq = u >> 2, b = rowq / SEQ, t = rowq % SEQ;
        {
            const f32x4 qs4 = *(const f32x4*)(ksq + ((size_t)rowq * 8 + hd) * 4);
            const float rq = 1.f / sqrtf(((qs4[0] + qs4[1]) + (qs4[2] + qs4[3])) * (1.f / 128.f) + EPS);
            const unsigned qq = *(const unsigned*)(proj + (size_t)rowq * DIN + 1024 + hd * 128 + 2 * lane);
            qsh[2 * lane] = bflo(qq) * rq * qg[2 * lane] * kg[2 * lane] * c2;
            qsh[2 * lane + 1] = bfhi(qq) * rq * qg[2 * lane + 1] * kg[2 * lane + 1] * c2;
        }
        float R = 0.f, o0 = 0.f, o1 = 0.f;
        for (int base = t - 1; base >= 0; base -= 64) {
            const int key = base - lane; const bool valid = key >= 0; const size_t rowk = (size_t)b * SEQ + (valid ? key : 0);
            const f32x4 ks4 = *(const f32x4*)(ksq + (rowk * 8 + 4 + hd) * 4);
            const float rk = 1.f / sqrtf(((ks4[0] + ks4[1]) + (ks4[2] + ks4[3])) * (1.f / 128.f) + EPS);
            const u32x4* kp = (const u32x4*)(proj + rowk * DIN + 1536 + hd * 128);
            float dot = 0.f;
#pragma unroll 4
            for (int c = 0; c < 16; ++c) { const u32x4 w = kp[c]; const f32x4 qa = *(const LAS f32x4*)(qsh + 8 * c), qb = *(const LAS f32x4*)(qsh + 8 * c + 4);
                dot += bflo(w.x) * qa[0] + bfhi(w.x) * qa[1] + bflo(w.y) * qa[2] + bfhi(w.y) * qa[3] + bflo(w.z) * qb[0] + bfhi(w.z) * qb[1] + bflo(w.w) * qb[2] + bfhi(w.w) * qb[3]; }
            const float z2 = dot * rk;
            const float L = valid ? -__builtin_amdgcn_logf(1.f + __builtin_amdgcn_exp2f(z2)) : 0.f;
            float P = L;
#pragma unroll
            for (int o = 1; o < 64; o <<= 1) { const float n = __shfl_up(P, o); if (lane >= o) P += n; }
            const float Aw = valid ? __builtin_amdgcn_exp2f(z2 + P + R) : 0.f;
            R += __shfl(P, 63);
            const int nk = (base + 1) < 64 ? (base + 1) : 64;
            for (int j = 0; j < nk; ++j) { const float a = __shfl(Aw, j);
                const unsigned vv = *(const unsigned*)(proj + ((size_t)b * SEQ + base - j) * DIN + 2048 + hd * 128 + 2 * lane);
                o0 += a * bflo(vv); o1 += a * bfhi(vv); }
            if (R < -150.f) break;
        }
        const float ss = wave_sum(o0 * o0 + o1 * o1);
        const float rs = 1.f / sqrtf(ss * (1.f / 128.f) + EPS);
        const float* og = out_norm_g + 512 + hd * 128 + 2 * lane;
        *(unsigned*)(ymix + (size_t)rowq * DMIX + 512 + hd * 128 + 2 * lane) = pk2(o0 * rs * og[0], o1 * rs * og[1]);
    }
}

__device__ __forceinline__ void phase_router(Frame& F, const ArgV A, int l, const float* x) {
    const int tid_ = fresh_tid(), lane_ = tid_ & 63; (void)tid_; (void)lane_;
    const float* modv = (const float*)(A.ws() + WS_MODV); bf16_t* hout = (bf16_t*)(A.ws() + WS_H);
    int* tok = (int*)(A.ws() + WS_TOK); int* list = (int*)(A.ws() + WS_LIST);
    const float *w_group_ = A.in(15) + (size_t)l * DM * 4, *b_group = A.in(16) + l * 4, *w_route_ = A.in(17) + (size_t)l * DM * 32, *b_route = A.in(18) + l * 32;
    const int lane = lane_;
    for (int blk = F.vcu; blk < NT / 128; blk += F.G) {
        const int b = (blk * 128) / SEQ;
        const float* mA_ = modv + ((size_t)(l * NB + b) * 6 + 4) * DM; const float* mS_ = modv + ((size_t)(l * NB + b) * 6 + 3) * DM;
#pragma unroll 1
        for (int i = 0; i < 16; ++i) {
            const int row = blk * 128 + F.wave * 16 + i;
            const float *mA = mA_, *mS = mS_, *w_route = w_route_, *w_group = w_group_;
            asm volatile("" : "+s"(mA), "+s"(mS), "+s"(w_route), "+s"(w_group));
            const f32x4* xr = (const f32x4*)(x + (size_t)row * DM) + lane;
            f32x4 v[8]; float ss = 0.f;
#pragma unroll
            for (int j = 0; j < 8; ++j) { v[j] = xr[64 * j]; ss += (v[j][0] * v[j][0] + v[j][1] * v[j][1]) + (v[j][2] * v[j][2] + v[j][3] * v[j][3]); }
            const float rstd = 1.f / sqrtf(wave_sum(ss) * (1.f / DM) + EPS);
            u32x2* ho = (u32x2*)(hout + (size_t)row * DM) + lane;
#pragma unroll
            for (int j = 0; j < 8; ++j) { const f32x4 a = *((const f32x4*)mA + lane + 64 * j), s = *((const f32x4*)mS + lane + 64 * j);
                v[j][0] = v[j][0] * rstd * a[0] + s[0]; v[j][1] = v[j][1] * rstd * a[1] + s[1]; v[j][2] = v[j][2] * rstd * a[2] + s[2]; v[j][3] = v[j][3] * rstd * a[3] + s[3];
                u32x2 o; o.x = pk2(v[j][0], v[j][1]); o.y = pk2(v[j][2], v[j][3]); ho[64 * j] = o; }
            float ar[32]; float ag[4] = {0.f, 0.f, 0.f, 0.f};
#pragma unroll
            for (int j = 0; j < 32; ++j) ar[j] = 0.f;
            LAS f32x4* hs = (LAS f32x4*)(F.lds + F.wave * 9728);
#pragma unroll
            for (int j = 0; j < 8; ++j) hs[64 * j + lane] = v[j];
            asm volatile("s_waitcnt lgkmcnt(0)" ::: "memory");
#pragma unroll 1
            for (int j = 0; j < 8; ++j) {
                const f32x4 hv4 = hs[64 * j + lane];
#pragma unroll
                for (int e = 0; e < 4; ++e) { const int k = 4 * lane + 256 * j + e; const float hv = hv4[e];
                    const f32x4* wr = (const f32x4*)(w_route + (size_t)k * 32); const f32x4 wg = *(const f32x4*)(w_group + (size_t)k * 4);
                    ag[0] += hv * wg[0]; ag[1] += hv * wg[1]; ag[2] += hv * wg[2]; ag[3] += hv * wg[3];
#pragma unroll
                    for (int q = 0; q < 8; ++q) { const f32x4 w = wr[q]; ar[q * 4 + 0] += hv * w[0]; ar[q * 4 + 1] += hv * w[1]; ar[q * 4 + 2] += hv * w[2]; ar[q * 4 + 3] += hv * w[3]; }
                    asm volatile("" ::: "memory"); }
            }
            {
                LAS float* red = (LAS float*)(F.lds + F.wave * 9728);
                asm volatile("s_waitcnt lgkmcnt(0)" ::: "memory");
#pragma unroll
                for (int q = 0; q < 32; ++q) red[lane * 37 + q] = ar[q];
#pragma unroll
                for (int q = 0; q < 4; ++q) red[lane * 37 + 32 + q] = ag[q];
                asm volatile("s_waitcnt lgkmcnt(0)" ::: "memory");
            }
            float lr = 0.f;
            {
                const LAS float* red = (const LAS float*)(F.lds + F.wave * 9728) + (lane < 36 ? lane : 0);
#pragma unroll 8
                for (int r = 0; r < 64; ++r) lr += red[r * 37];
                asm volatile("s_waitcnt lgkmcnt(0)" ::: "memory");
            }
            float gl[4];
#pragma unroll
            for (int q = 0; q < 4; ++q) gl[q] = __shfl(lr, 32 + q) + b_group[q];
            lr += b_route[lane & 31];
            int gi = 0; float gm = gl[0];
#pragma unroll
            for (int q = 1; q < 4; ++q) if (gl[q] > gm) { gm = gl[q]; gi = q; }
            float den = 0.f;
#pragma unroll
            for (int q = 0; q < 4; ++q) den += __expf(gl[q] - gm);
            const float pg = 1.f / den;
            float ev[8];
#pragma unroll
            for (int q = 0; q < 8; ++q) ev[q] = __shfl(lr, gi * 8 + q);
            int i0 = 0; float v0 = ev[0];
#pragma unroll
            for (int q = 1; q < 8; ++q) if (ev[q] > v0) { v0 = ev[q]; i0 = q; }
            int i1 = -1; float v1 = -3.0e38f;
#pragma unroll
            for (int q = 0; q < 8; ++q) if (q != i0 && ev[q] > v1) { v1 = ev[q]; i1 = q; }
            const float e1x = __expf(v1 - v0); const float w0 = pg / (1.f + e1x), w1 = pg * e1x / (1.f + e1x);
            if (lane == 0) {
                const int e0 = gi * 8 + i0, e1 = gi * 8 + i1;
                const int p0 = (int)atomicAdd(F.ctl + CW_CNT + (l * 32 + e0) * 64, 1u), p1 = (int)atomicAdd(F.ctl + CW_CNT + (l * 32 + e1) * 64, 1u);
                list[(size_t)e0 * NT + p0] = row; list[(size_t)e1 * NT + p1] = row;
                tok[row * 8 + 0] = e0; tok[row * 8 + 1] = e1; tok[row * 8 + 2] = p0; tok[row * 8 + 3] = p1;
                tok[row * 8 + 4] = __builtin_bit_cast(int, w0); tok[row * 8 + 5] = __builtin_bit_cast(int, w1);
            }
        }
    }
}

__global__ void __launch_bounds__(512, 2) fwd_kernel(Args args_unused) {
    extern __shared__ __attribute__((aligned(16))) unsigned char lds_raw[];
    Frame F;
    F.lds = (LAS unsigned char*)lds_raw;
    F.MISC = (volatile LAS unsigned*)(F.lds + MISC_OFF);
    F.tid = threadIdx.x; F.lane = F.tid & 63; F.wave = __builtin_amdgcn_readfirstlane(F.tid >> 6);
    F.G = gridDim.x; { const int bx = blockIdx.x; F.vcu = (F.G % 8 == 0) ? (bx % 8) * (F.G / 8) + bx / 8 : bx; }
    F.gw = F.vcu * 8 + F.wave; F.NGW = F.G * 8;
    { const ArgV a0 = get_args(); F.ctl = (unsigned*)(a0.ws() + WS_CTL); }
    for (int u = F.tid; u < 256; u += 512) F.MISC[u] = 0u;
    __syncthreads();
    int lo, hi; { const ArgV a0 = get_args(); lo = a0.ph_lo(); hi = a0.ph_hi(); }
    XcdBarrier bar; bar.bar = F.ctl + CW_BAR; bar.x = 0; bar.st = nullptr;
    if (hi - lo > 1) bar = xcd_barrier_post(F.ctl + CW_BAR, F.MISC);
#ifndef PH_MASK
#define PH_MASK 0x1ff
#endif
#define PM(j) (((PH_MASK) >> (j)) & 1)
#define IN(k) (lo <= (k) && (k) < hi)
#define SEAM(k) do { if (IN(k) && IN((k) + 1)) xcd_barrier(bar); } while (0)
    if (PM(0) && IN(0)) { const ArgV args = get_args(); phase_modpart(F, args.in(1), args.in(2), (float*)(args.ws() + WS_MODPART)); } SEAM(0);
    if (PM(0) && IN(1)) { const ArgV args = get_args(); phase_prep(F, args); } SEAM(1);
    for (int l = 0; l < NL; ++l) {
        const int pb = 2 + 7 * l;
        if (PM(1) && IN(pb + 0)) { const ArgV args = get_args(); float* xres = args.out(); phase_norm1<true>(F, args, l, l > 0, l == 0 ? args.in(0) : xres, xres, true); } SEAM(pb + 0);
        if (PM(2) && IN(pb + 1)) {
            const ArgV args = get_args();
            DenseSched S; S.init(NT, DIN, DM, (const bf16_t*)(args.ws() + WS_WINT) + (size_t)l * DIN * DM, F.G, (int)blockIdx.x);
            EpiProj E{(bf16_t*)(args.ws() + WS_PROJ), (float*)(args.ws() + WS_KSQ)};
            pg8::gemm_phase<EpiProj, DenseSched>(F.lds, (const bf16_t*)(args.ws() + WS_H), DM, S, E);
        } SEAM(pb + 1);
        if (IN(pb + 2)) { if (PM(3)) { const ArgV args = get_args(); phase_gmlp(F, args, l); } if (PM(4)) { const ArgV args = get_args(); phase_attn(F, args, l); } } SEAM(pb + 2);
        if (PM(7) && IN(pb + 3)) {
            const ArgV args = get_args(); float* xres = args.out();
            DenseSched S; S.init(NT, DM, DMIX, (const bf16_t*)(args.ws() + WS_WOUTT) + (size_t)l * DM * DMIX, F.G, (int)blockIdx.x);
            EpiOut E{xres, (const float*)(args.ws() + WS_MODV) + ((size_t)(l * NB) * 6 + 2) * DM};
            pg8::gemm_phase<EpiOut, DenseSched>(F.lds, (const bf16_t*)(args.ws() + WS_YMIX), DMIX, S, E);
        } SEAM(pb + 3);
        if (PM(5) && IN(pb + 4)) { const ArgV args = get_args(); phase_router(F, args, l, args.out()); } SEAM(pb + 4);
        if (PM(6) && IN(pb + 5)) {
            const ArgV args = get_args();
            build_tiles(F, l);
            MoeSched<true> S; S.tp = F.MISC + 16; S.cnt = F.MISC + 64; S.te = (const volatile LAS unsigned*)(F.lds + TILE_E_OFF); S.list = (const int*)(args.ws() + WS_LIST);
            S.Bt = (const bf16_t*)(args.ws() + WS_WGUT) + (size_t)l * NE * 512 * DM; S.bstride_e = (size_t)512 * DM; S.K = DM; S.npn = 2; S.lognpn = 1; S.G = F.G; S.c = F.vcu;
            EpiAct E{(bf16_t*)(args.ws() + WS_ACT)};
            pg8::gemm_phase<EpiAct, MoeSched<true> >(F.lds, (const bf16_t*)(args.ws() + WS_H), DM, S, E);
        } SEAM(pb + 5);
        if (PM(8) && IN(pb + 6)) {
            const ArgV args = get_args();
            build_tiles(F, l);
            MoeSched<false> S; S.tp = F.MISC + 16; S.cnt = F.MISC + 64; S.te = (const volatile LAS unsigned*)(F.lds + TILE_E_OFF); S.list = nullptr;
            S.Bt = (const bf16_t*)(args.ws() + WS_WDT) + (size_t)l * NE * DM * DE; S.bstride_e = (size_t)DM * DE; S.K = DE; S.npn = 8; S.lognpn = 3; S.G = F.G; S.c = F.vcu;
            EpiY E{(bf16_t*)(args.ws() + WS_YSLOT)};
            pg8::gemm_phase<EpiY, MoeSched<false> >(F.lds, (const bf16_t*)(args.ws() + WS_ACT), DE, S, E);
        } SEAM(pb + 6);
    }
    if (PM(1) && IN(30)) { const ArgV args = get_args(); float* xres = args.out(); phase_norm1<false>(F, args, NL, true, xres, xres, true); }
#undef IN
#undef SEAM
}

extern "C" void kernel_launch(void* const* d_in, const int* in_sizes, int n_in, void* d_out, int out_size, void* d_ws, size_t ws_size, hipStream_t stream) {
    static int grid = 0;
    if (grid == 0) {
        if (n_in != 22 || out_size != NT * DM || ws_size < WS_END) { fprintf(stderr, "kernel_launch: unexpected problem (n_in %d out %d ws %zu)\n", n_in, out_size, ws_size); grid = -1; return; }
        int dev = 0, cus = 0;
        if (hipGetDevice(&dev) != hipSuccess || hipDeviceGetAttribute(&cus, hipDeviceAttributeMultiprocessorCount, dev) != hipSuccess) { grid = -1; return; }
        if (hipFuncSetAttribute((const void*)fwd_kernel, hipFuncAttributeMaxDynamicSharedMemorySize, LDS_BYTES) != hipSuccess) { fprintf(stderr, "kernel_launch: hipFuncSetAttribute failed\n"); grid = -1; return; }
        int per_cu = 0;
        (void)hipOccupancyMaxActiveBlocksPerMultiprocessor(&per_cu, (const void*)fwd_kernel, 512, LDS_BYTES);
        (void)hipGetLastError();
        grid = cus;
    }
    if (grid < 0) return;
    (void)hipMemsetAsync((char*)d_ws + WS_CTL, 0, CTL_ZERO_BYTES, stream);
    Args a{};
    for (int i = 0; i < 22; ++i) a.in[i] = (const float*)d_in[i];
    a.out = (float*)d_out; a.ws = (unsigned char*)d_ws;
#if MK_ONE_LAUNCH
    a.ph_lo = 0; a.ph_hi = NPHASE;
    hipLaunchKernelGGL(fwd_kernel, dim3(grid), dim3(512), LDS_BYTES, stream, a);
#else
    for (int p = 0; p < NPHASE; ++p) { a.ph_lo = p; a.ph_hi = p + 1; hipLaunchKernelGGL(fwd_kernel, dim3(grid), dim3(512), LDS_BYTES, stream, a); }
#endif
}
```

```cpp
#include <hip/hip_runtime.h>
#include <cstdio>
#include <cstdint>

#ifndef MK_ONE_LAUNCH
#define MK_ONE_LAUNCH 1
#endif

#define LAS __attribute__((address_space(3)))
#define GAS __attribute__((address_space(1)))
typedef unsigned short bf16_t;
typedef short bf16x8 __attribute__((ext_vector_type(8)));
typedef float f32x4 __attribute__((ext_vector_type(4)));
typedef float f32x2 __attribute__((ext_vector_type(2)));
typedef float f32x16 __attribute__((ext_vector_type(16)));
typedef unsigned u32x4 __attribute__((ext_vector_type(4)));
typedef unsigned u32x2 __attribute__((ext_vector_type(2)));
typedef __bf16 bf16x2_t __attribute__((ext_vector_type(2)));

constexpr int DM = 2048, NB = 4, SEQ = 8192, NL = 4, NT = NB * SEQ;
constexpr int DIN = 2560, DMIX = 1024, NE = 32, DE = 256, NMOD = 6 * DM;
constexpr int SLOT_TILES = NT * 2 / 256 + NE, NSLOT = SLOT_TILES * 256;
constexpr float EPS = 1e-6f;
constexpr int NPHASE = 31;

constexpr size_t MiB = 1u << 20;
constexpr size_t WS_CTL = 0, CTL_ZERO_BYTES = 1 * MiB;
constexpr size_t WS_MODPART = 1 * MiB;
constexpr size_t WS_MODV = 2 * MiB;
constexpr size_t WS_TOK = 3 * MiB;
constexpr size_t WS_LIST = 4 * MiB;
constexpr size_t WS_KSQ = 8 * MiB;
constexpr size_t WS_WINT = 12 * MiB;
constexpr size_t WS_WOUTT = 52 * MiB;
constexpr size_t WS_WGUT = 68 * MiB;
constexpr size_t WS_WDT = 324 * MiB;
constexpr size_t WS_H = 452 * MiB;
constexpr size_t WS_PROJ = 580 * MiB;
constexpr size_t WS_YMIX = 740 * MiB;
constexpr size_t WS_ACT = 804 * MiB;
constexpr size_t WS_YSLOT = 840 * MiB;
constexpr size_t WS_WRT = 1128 * MiB;
constexpr size_t WS_END = 1129 * MiB;
static_assert(WS_ACT + (size_t)NSLOT * 256 * 2 <= WS_YSLOT && WS_YSLOT + (size_t)NSLOT * 2048 * 2 <= WS_WRT, "ws map");
constexpr int CW_BAR = 4096;
constexpr int CW_CNT = 16384;

constexpr int LDS_BYTES = 147456;
constexpr int TILE_E_OFF = 131072;
constexpr int OFFN_OFF = 133120;
constexpr int MISC_OFF = 147456 - 1024;

#define RLX_AGENT __ATOMIC_RELAXED, __HIP_MEMORY_SCOPE_AGENT
__device__ __forceinline__ unsigned f2bf(float f) { unsigned u = __builtin_bit_cast(unsigned, f); return (u + 0x7fffu + ((u >> 16) & 1u)) >> 16; }
__device__ __forceinline__ unsigned pk2(float lo, float hi) { f32x2 v = {lo, hi}; bf16x2_t b = __builtin_convertvector(v, bf16x2_t); return __builtin_bit_cast(unsigned, b); }
__device__ __forceinline__ float bflo(unsigned u) { return __builtin_bit_cast(float, u << 16); }
__device__ __forceinline__ float bfhi(unsigned u) { return __builtin_bit_cast(float, u & 0xffff0000u); }
__device__ __forceinline__ float wave_sum(float v) {
#pragma unroll
    for (int o = 1; o < 64; o <<= 1) v += __shfl_xor(v, o);
    return v;
}
__device__ __forceinline__ int fresh_tid() { int t = threadIdx.x; asm volatile("" : "+v"(t)); return t; }
__device__ __forceinline__ float gelu_exact(float x) { return 0.5f * x * (1.f + erff(x * 0.70710678118654752f)); }
__device__ __forceinline__ float silu_f(float x) { return x / (1.f + __expf(-x)); }

#define XB_TMO      128
#define XB_XCNT(j)  (256  + 64 * (j))
#define XB_XSUB(j)  (1280 + 64 * (j))
#define XB_XGEN(j)  (2304 + 64 * (j))
#define XB_TOP      3328
#define XB_TOPGEN   3392
#define XCD_BAR_WORDS 3456
#define XB_SPIN_CAP (1u << 22)
__device__ __forceinline__ unsigned xb_ld(unsigned* p)              { return __hip_atomic_load(p, __ATOMIC_RELAXED, __HIP_MEMORY_SCOPE_AGENT); }
__device__ __forceinline__ unsigned xb_add(unsigned* p, unsigned v) { return __hip_atomic_fetch_add(p, v, __ATOMIC_RELAXED, __HIP_MEMORY_SCOPE_AGENT); }
__device__ __forceinline__ unsigned xb_xcc_id() { return (unsigned)__builtin_amdgcn_s_getreg((3 << 11) | 20) & 0xFu; }
#define XB_SPIN(cond, bar) do { unsigned _sp = 0; while (cond) { __builtin_amdgcn_s_sleep(1); \
    if ((++_sp & 255u) == 0u) { if (xb_ld(&(bar)[XB_TMO])) break; if (_sp > XB_SPIN_CAP) { atomicAdd(&(bar)[XB_TMO], 1u); break; } } } } while (0)
struct XcdBarrier { unsigned* bar; unsigned x; volatile LAS unsigned* st; };
__device__ __forceinline__ XcdBarrier xcd_barrier_post(unsigned* bar, volatile LAS unsigned* st) {
    XcdBarrier b; b.bar = bar; b.x = xb_xcc_id(); b.st = st;
    if (threadIdx.x == 0) (void)xb_add(&bar[XB_XCNT(b.x)], 1u);
    return b;
}
__device__ __forceinline__ void xcd_barrier_complete(unsigned* bar, unsigned x, unsigned& nloc, unsigned& nx) {
    const unsigned G = gridDim.x * gridDim.y * gridDim.z;
    unsigned sum, cnt, mine, sp = 0u;
    for (;;) {
        sum = 0u; cnt = 0u; mine = 0u;
#pragma unroll
        for (unsigned j = 0; j < 16; ++j) { const unsigned c = xb_ld(&bar[XB_XCNT(j)]); sum += c; cnt += (c > 0u) ? 1u : 0u; mine = (j == x) ? c : mine; }
        if (sum == G) break;
        __builtin_amdgcn_s_sleep(1);
        if ((++sp & 255u) == 0u) { if (xb_ld(&bar[XB_TMO])) break; if (sp > XB_SPIN_CAP) { atomicAdd(&bar[XB_TMO], 1u); break; } }
    }
    nloc = mine > 0u ? mine : 1u; nx = cnt > 0u ? cnt : 1u;
}
__device__ __forceinline__ void xcd_barrier(const XcdBarrier& b) {
    asm volatile("s_waitcnt vmcnt(0)" ::: "memory");
    __syncthreads();
    if (threadIdx.x == 0) {
        unsigned* bar = b.bar; unsigned bx = b.x;
        asm volatile("" : "+s"(bar), "+s"(bx));
        __builtin_amdgcn_s_waitcnt(0);
        unsigned nloc = b.st[0], nx = b.st[1];
        if (nloc == 0u) { xcd_barrier_complete(bar, bx, nloc, nx); b.st[0] = nloc; b.st[1] = nx; }
        const unsigned old = xb_add(&bar[XB_XSUB(bx)], 1u);
        const unsigned gen = old / nloc;
        if (old + 1u == (gen + 1u) * nloc) {
            __builtin_amdgcn_fence(__ATOMIC_RELEASE, "agent");
            asm volatile("s_waitcnt vmcnt(0)" ::: "memory");
            const unsigned og = xb_add(&bar[XB_TOP], 1u);
            const unsigned tg = og / nx;
            if (og + 1u == (tg + 1u) * nx) xb_add(&bar[XB_TOPGEN], 1u);
            else XB_SPIN(xb_ld(&bar[XB_TOPGEN]) == tg, bar);
            __builtin_amdgcn_fence(__ATOMIC_ACQUIRE, "agent");
            xb_add(&bar[XB_XGEN(bx)], 1u);
            asm volatile("s_waitcnt vmcnt(0)" ::: "memory");
        } else {
            XB_SPIN(xb_ld(&bar[XB_XGEN(bx)]) == gen, bar);
            __builtin_amdgcn_fence(__ATOMIC_ACQUIRE, "agent");
            asm volatile("s_waitcnt vmcnt(0)" ::: "memory");
        }
    }
    __syncthreads();
}

namespace pg8 {
constexpr int BM = 256, BK = 64, HALF = 128, HTB = HALF * BK * 2, NXCD = 8, WGM = 8;
__device__ __forceinline__ int lds_byte(int r, int c) { const int st = (r >> 4) * 2 + (c >> 5), rr = r & 15, cc = c & 31, ob = rr * 64 + cc * 2; return st * 1024 + (ob ^ (((ob >> 9) & 1) << 5)); }
__device__ __forceinline__ void stage_rc(int b, int& R, int& C) { const int st = b / 1024, sb = b % 1024, swz = sb ^ (((sb >> 9) & 1) << 5); R = (st >> 1) * 16 + swz / 64; C = (st & 1) * 32 + (swz % 64) / 2; }
__device__ __forceinline__ int perm32(int rho) { const int n = rho >> 4, i = rho & 15; return 8 * (i >> 2) + 4 * n + (i & 3); }

template <class Epi, class Sched>
__device__ __forceinline__ void gemm_phase(LAS unsigned char* lds, const bf16_t* Abase, const int K, const Sched& S, const Epi& E) {
    typedef typename Sched::Unit Unit;
    constexpr bool GATHER = Sched::GATHER;
    const int tid = fresh_tid(), wid = __builtin_amdgcn_readfirstlane(tid >> 6), lane = tid & 63, wr = wid >> 2, wc = wid & 3, fr = lane & 15, fq = lane >> 4;
    const int nt = K / BK;
    unsigned voffA[2], voffB[2];
#pragma unroll
    for (int i = 0; i < 2; ++i) { int R, C; stage_rc(tid * 16 + i * 8192, R, C); const int Rb = Epi::PERM ? ((R & ~31) + perm32(R & 31)) : R;
        voffA[i] = (unsigned)(R * K + C) * 2u; voffB[i] = (unsigned)(Rb * K + C) * 2u; }
    const size_t kstep = (size_t)(BK * 2);
    const size_t hstep = (size_t)HALF * K * 2;
    const unsigned ldsw0 = (unsigned)wid * 1024u; unsigned ldsw = ldsw0;
    const int aoff = lds_byte(wr * 64 + fr, fq * 8), boff = lds_byte(wc * 32 + fr, fq * 8);
    const char* Ab = (const char*)Abase;
#define PG8_SA(b, h) (((b) * 2 + (h)) * HTB)
#define PG8_SB(b, h) ((4 + (b) * 2 + (h)) * HTB)
#define PG8_STAGE(bufoff, gbase, voff) do { _Pragma("unroll") for (int _i = 0; _i < 2; ++_i) \
        __builtin_amdgcn_global_load_lds((const unsigned*)((const char*)(gbase) + (voff)[_i]), (LAS unsigned*)(lds + (bufoff) + ldsw + _i * 8192), 16, 0, 0); } while (0)
#define PG8_STAGEA(bufoff, p, kb, off, h) do { if constexpr (GATHER) { PG8_STAGE(bufoff, Ab + (kb), (off) + 2 * (h)); } else { PG8_STAGE(bufoff, (p) + (h) * hstep, voffA); } } while (0)
#define PG8_LDA(dst, b, h) do { _Pragma("unroll") for (int m = 0; m < 4; ++m) _Pragma("unroll") for (int k = 0; k < 2; ++k) dst[m][k] = *(const LAS bf16x8*)(lds + PG8_SA(b, h) + aoff + m * 2048 + k * 1024); } while (0)
#define PG8_LDB(dst, b, h) do { _Pragma("unroll") for (int n = 0; n < 2; ++n) _Pragma("unroll") for (int k = 0; k < 2; ++k) dst[n][k] = *(const LAS bf16x8*)(lds + PG8_SB(b, h) + boff + n * 2048 + k * 1024); } while (0)
#define PG8_MMA(ai, bj, At, Bt) do { __builtin_amdgcn_s_setprio(1); _Pragma("unroll") for (int m = 0; m < 4; ++m) _Pragma("unroll") for (int n = 0; n < 2; ++n) _Pragma("unroll") for (int k = 0; k < 2; ++k) \
        acc[ai][bj][m][n] = __builtin_amdgcn_mfma_f32_16x16x32_bf16(Bt[n][k], At[m][k], acc[ai][bj][m][n], 0, 0, 0); __builtin_amdgcn_s_setprio(0); } while (0)
#define PG8_WAIT_V(n) asm volatile("s_waitcnt vmcnt(" #n ")" ::: "memory")
#define PG8_WAIT_L(n) asm volatile("s_waitcnt lgkmcnt(" #n ")" ::: "memory")
#define PG8_BAR __builtin_amdgcn_s_barrier()
#define PG8_SCHED __builtin_amdgcn_sched_barrier(0)
#define PG8_AOFF(u, dst) do { _Pragma("unroll") for (int _h = 0; _h < 2; ++_h) _Pragma("unroll") for (int _i = 0; _i < 2; ++_i) { \
        int _R, _C; stage_rc(tid * 16 + _i * 8192, _R, _C); dst[_h * 2 + _i] = (S.arow(u, _h * HALF + _R) * (unsigned)K + (unsigned)_C) * 2u; } } while (0)
    Unit cur, nxt; int ui = 0;
    if (!S.next(0, cur)) return;
    f32x4 acc[2][2][4][2];
#pragma unroll
    for (int a = 0; a < 2; ++a)
#pragma unroll
        for (int b = 0; b < 2; ++b)
#pragma unroll
            for (int m = 0; m < 4; ++m)
#pragma unroll
                for (int n = 0; n < 2; ++n) acc[a][b][m][n] = (f32x4){0.f, 0.f, 0.f, 0.f};
    bf16x8 At[4][2], B0[2][2], B1[2][2];
    unsigned offc[4] = {0u, 0u, 0u, 0u}, offn[4] = {0u, 0u, 0u, 0u};
    volatile LAS unsigned* onx = (volatile LAS unsigned*)(lds + OFFN_OFF) + tid * 4;
    if constexpr (GATHER) PG8_AOFF(cur, offc);
    const char* cA = GATHER ? Ab : S.aptr(cur, Ab);
    const char* cB = S.bptr(cur);
    PG8_STAGE(PG8_SB(0, 0), cB, voffB); PG8_STAGE(PG8_SB(0, 1), cB + hstep, voffB); PG8_STAGEA(PG8_SA(0, 0), cA, 0, offc, 0); PG8_STAGEA(PG8_SA(0, 1), cA, 0, offc, 1);
    if (wr == 1) PG8_BAR;
    PG8_WAIT_V(2); PG8_BAR;
    PG8_STAGE(PG8_SB(1, 0), cB + kstep, voffB); PG8_STAGEA(PG8_SA(1, 0), cA + kstep, kstep, offc, 0); PG8_STAGE(PG8_SB(1, 1), cB + hstep + kstep, voffB);
    PG8_WAIT_V(6); PG8_BAR;
    for (;;) {
        const bool has_next = S.next(ui + 1, nxt);
        const char* nA = cA; const char* nB = cB;
        if (has_next) { nB = S.bptr(nxt); if constexpr (!GATHER) nA = S.aptr(nxt, Ab);
            if constexpr (GATHER) { unsigned tmp[4]; PG8_AOFF(nxt, tmp);
#pragma unroll
                for (int j = 0; j < 4; ++j) onx[j] = tmp[j]; } }
#pragma unroll 1
        for (int t = 0; t < nt; t += 2) {
            const bool last = (t == nt - 2);
            unsigned ldsw = ldsw0; asm volatile("" : "+s"(ldsw));
            const char* a1 = cA + (size_t)(t + 1) * kstep; const size_t k1 = (size_t)(t + 1) * kstep;
            const char* a2 = last ? nA : cA + (size_t)(t + 2) * kstep; const size_t k2 = last ? 0 : (size_t)(t + 2) * kstep;
            const char* b2 = last ? nB : cB + (size_t)(t + 2) * kstep;
            const char* a3 = a2 + kstep; const char* b3 = b2 + kstep; const size_t k3 = k2 + kstep;
            if constexpr (GATHER) {
#pragma unroll
                for (int j = 0; j < 4; ++j) offn[j] = offc[j];
                if (last && has_next) {
#pragma unroll
                    for (int j = 0; j < 4; ++j) offn[j] = onx[j];
                }
            }
            PG8_LDB(B0, 0, 0); PG8_LDB(B1, 0, 1); PG8_SCHED; PG8_LDA(At, 0, 0); PG8_STAGEA(PG8_SA(1, 1), a1, k1, offc, 1);
            PG8_WAIT_V(8); PG8_WAIT_L(0); PG8_BAR; PG8_MMA(0, 0, At, B0); PG8_MMA(0, 1, At, B1); PG8_BAR; PG8_SCHED;
            PG8_LDA(At, 0, 1); PG8_STAGE(PG8_SB(0, 0), b2, voffB); PG8_STAGE(PG8_SB(0, 1), b2 + hstep, voffB); PG8_STAGEA(PG8_SA(0, 0), a2, k2, offn, 0);
            PG8_WAIT_V(8); PG8_WAIT_L(0); PG8_BAR; PG8_MMA(1, 0, At, B0); PG8_MMA(1, 1, At, B1); PG8_BAR; PG8_SCHED;
            PG8_LDB(B0, 1, 0); PG8_LDB(B1, 1, 1); PG8_SCHED; PG8_LDA(At, 1, 0); PG8_STAGEA(PG8_SA(0, 1), a2, k2, offn, 1);
            PG8_WAIT_V(8); PG8_WAIT_L(0); PG8_BAR; PG8_MMA(0, 0, At, B0); PG8_MMA(0, 1, At, B1); PG8_BAR; PG8_SCHED;
            PG8_LDA(At, 1, 1); PG8_STAGE(PG8_SB(1, 0), b3, voffB); PG8_STAGE(PG8_SB(1, 1), b3 + hstep, voffB); PG8_STAGEA(PG8_SA(1, 0), a3, k3, offn, 0);
            PG8_WAIT_V(8); PG8_WAIT_L(0); PG8_BAR; PG8_MMA(1, 0, At, B0); PG8_MMA(1, 1, At, B1); PG8_BAR; PG8_SCHED;
        }
        if (wr == 0) PG8_BAR;
        E(acc, cur, wr, wc, fr, fq);
        if (!has_next) break;
#pragma unroll
        for (int a = 0; a < 2; ++a)
#pragma unroll
            for (int b = 0; b < 2; ++b)
#pragma unroll
                for (int m = 0; m < 4; ++m)
#pragma unroll
                    for (int n = 0; n < 2; ++n) acc[a][b][m][n] = (f32x4){0.f, 0.f, 0.f, 0.f};
        cur = nxt; cA = nA; cB = nB; ++ui;
        if constexpr (GATHER) {
#pragma unroll
            for (int j = 0; j < 4; ++j) offc[j] = onx[j];
        }
        if (wr == 1) PG8_BAR;
    }
    PG8_WAIT_V(0);
    PG8_BAR;
#undef PG8_SA
#undef PG8_SB
#undef PG8_STAGE
#undef PG8_STAGEA
#undef PG8_LDA
#undef PG8_LDB
#undef PG8_MMA
#undef PG8_WAIT_V
#undef PG8_WAIT_L
#undef PG8_BAR
#undef PG8_SCHED
#undef PG8_AOFF
}
}

struct DenseUnit { int pm, pn; };
struct DenseSched {
    typedef DenseUnit Unit;
    int nM, nN, nwg, G, c; const bf16_t* Bt; int K;
    __device__ __forceinline__ void init(int M, int N, int K_, const bf16_t* Bt_, int G_, int c_) { nM = M / 256; nN = N / 256; nwg = nM * nN; G = G_; c = c_; Bt = Bt_; K = K_; }
    __device__ __forceinline__ bool next(int i, Unit& u) const {
        const long L = (long)i * G + c; if (L >= nwg) return false;
        int wgid = (int)L; { const int q = nwg / 8, r = nwg % 8, xcd = wgid % 8, off = wgid / 8; wgid = (xcd < r ? xcd * (q + 1) : r * (q + 1) + (xcd - r) * q) + off; }
        const int nig = 8 * nN, gid = wgid / nig, fm = gid * 8, gsz = (nM - fm) < 8 ? (nM - fm) : 8;
        u.pm = fm + ((wgid % nig) % gsz); u.pn = (wgid % nig) / gsz; return true;
    }
    static constexpr bool GATHER = false;
    __device__ __forceinline__ unsigned arow(const Unit& u, int r) const { return (unsigned)(u.pm * 256 + r); }
    __device__ __forceinline__ const char* aptr(const Unit& u, const char* Ab) const { return Ab + (size_t)u.pm * 256 * K * 2; }
    __device__ __forceinline__ const char* bptr(const Unit& u) const { return (const char*)(Bt + (size_t)u.pn * 256 * K); }
};
struct MoeUnit { int e, tile, rt, pn, cnt; };
template <bool GATHER_>
struct MoeSched {
    typedef MoeUnit Unit;
    static constexpr bool GATHER = GATHER_;
    const volatile LAS unsigned* tp;
    const volatile LAS unsigned* cnt;
    const volatile LAS unsigned* te;
    const int* list;
    const bf16_t* Bt; size_t bstride_e; int K; int npn, lognpn; int G, c;
    __device__ __forceinline__ bool next(int i, Unit& u) const {
        const int L = i * G + c; const int tile = L >> lognpn; const int ntile = __builtin_amdgcn_readfirstlane((int)tp[32]);
        if (tile >= ntile) return false;
        u.e = __builtin_amdgcn_readfirstlane((int)te[tile]); u.tile = tile; u.rt = tile - __builtin_amdgcn_readfirstlane((int)tp[u.e]);
        u.cnt = __builtin_amdgcn_readfirstlane((int)cnt[u.e]); u.pn = L & (npn - 1); return true;
    }
    __device__ __forceinline__ const char* aptr(const Unit& u, const char* Ab) const { return Ab + (size_t)u.tile * 256 * K * 2; }
    __device__ __forceinline__ unsigned arow(const Unit& u, int r) const {
        const int slot = u.rt * 256 + r;
        return (slot < u.cnt) ? (unsigned)list[(size_t)u.e * NT + slot] : 0u;
    }
    __device__ __forceinline__ const char* bptr(const Unit& u) const { return (const char*)(Bt + (size_t)u.e * bstride_e + (size_t)u.pn * 256 * K); }
};

struct EpiProj {
    static constexpr bool PERM = true;
    bf16_t* O; float* ksq;
    __device__ __forceinline__ void operator()(const f32x4 (&acc)[2][2][4][2], const DenseUnit& u, int wr, int wc, int fr, int fq) const {
        const int row0 = u.pm * 256 + wr * 64 + fr, col0 = u.pn * 256 + wc * 32 + 8 * fq;
        const bool qk = (u.pn >= 4 && u.pn < 8);
#pragma unroll
        for (int ai = 0; ai < 2; ++ai)
#pragma unroll
            for (int m = 0; m < 4; ++m) { const int row = row0 + ai * 128 + m * 16; bf16_t* rowp = O + (size_t)row * DIN + col0;
#pragma unroll
                for (int bj = 0; bj < 2; ++bj) { const f32x4 v0 = acc[ai][bj][m][0], v1 = acc[ai][bj][m][1];
                    u32x4 w; w.x = pk2(v0[0], v0[1]); w.y = pk2(v0[2], v0[3]); w.z = pk2(v1[0], v1[1]); w.w = pk2(v1[2], v1[3]);
                    *(u32x4*)(rowp + bj * 128) = w;
                    if (qk) { float ss = (v0[0] * v0[0] + v0[1] * v0[1]) + (v0[2] * v0[2] + v0[3] * v0[3]) + (v1[0] * v1[0] + v1[1] * v1[1]) + (v1[2] * v1[2] + v1[3] * v1[3]);
                        ss += __shfl_xor(ss, 16); ss += __shfl_xor(ss, 32);
                        if (fq == 0) ksq[((size_t)row * 8 + (u.pn - 4) * 2 + bj) * 4 + wc] = ss; } } }
    }
};
struct EpiOut {
    static constexpr bool PERM = false;
    float* X; const float* gate;
    __device__ __forceinline__ void operator()(const f32x4 (&acc)[2][2][4][2], const DenseUnit& u, int wr, int wc, int fr, int fq) const {
        const int row0 = u.pm * 256 + wr * 64 + fr, col0 = u.pn * 256 + wc * 32 + 4 * fq;
        const int b = (u.pm * 256) / SEQ;
        f32x4 gv[2][2];
#pragma unroll
        for (int bj = 0; bj < 2; ++bj)
#pragma unroll
            for (int n = 0; n < 2; ++n) gv[bj][n] = *(const f32x4*)(gate + (size_t)b * 6 * DM + col0 + bj * 128 + n * 16);
#pragma unroll
        for (int ai = 0; ai < 2; ++ai)
#pragma unroll
            for (int m = 0; m < 4; ++m) { float* rowp = X + (size_t)(row0 + ai * 128 + m * 16) * DM + col0;
#pragma unroll
                for (int bj = 0; bj < 2; ++bj)
#pragma unroll
                    for (int n = 0; n < 2; ++n) { f32x4* p = (f32x4*)(rowp + bj * 128 + n * 16); *p = *p + gv[bj][n] * acc[ai][bj][m][n]; }
                asm volatile("" ::: "memory"); }
    }
};
struct EpiAct {
    static constexpr bool PERM = true;
    bf16_t* O;
    __device__ __forceinline__ void operator()(const f32x4 (&acc)[2][2][4][2], const MoeUnit& u, int wr, int wc, int fr, int fq) const {
        const int row0 = u.tile * 256 + wr * 64 + fr, col0 = u.pn * 128 + wc * 32 + 8 * fq;
#pragma unroll
        for (int ai = 0; ai < 2; ++ai)
#pragma unroll
            for (int m = 0; m < 4; ++m) { bf16_t* rowp = O + (size_t)(row0 + ai * 128 + m * 16) * DE + col0;
                float r[8];
#pragma unroll
                for (int n = 0; n < 2; ++n)
#pragma unroll
                    for (int j = 0; j < 4; ++j) r[n * 4 + j] = silu_f(acc[ai][0][m][n][j]) * acc[ai][1][m][n][j];
                u32x4 w; w.x = pk2(r[0], r[1]); w.y = pk2(r[2], r[3]); w.z = pk2(r[4], r[5]); w.w = pk2(r[6], r[7]);
                *(u32x4*)rowp = w; }
    }
};
struct EpiY {
    static constexpr bool PERM = true;
    bf16_t* O;
    __device__ __forceinline__ void operator()(const f32x4 (&acc)[2][2][4][2], const MoeUnit& u, int wr, int wc, int fr, int fq) const {
        const int row0 = u.tile * 256 + wr * 64 + fr, col0 = u.pn * 256 + wc * 32 + 8 * fq;
#pragma unroll
        for (int ai = 0; ai < 2; ++ai)
#pragma unroll
            for (int m = 0; m < 4; ++m) { bf16_t* rowp = O + (size_t)(row0 + ai * 128 + m * 16) * DM + col0;
#pragma unroll
                for (int bj = 0; bj < 2; ++bj) { const f32x4 v0 = acc[ai][bj][m][0], v1 = acc[ai][bj][m][1];
                    u32x4 w; w.x = pk2(v0[0], v0[1]); w.y = pk2(v0[2], v0[3]); w.z = pk2(v1[0], v1[1]); w.w = pk2(v1[2], v1[3]);
                    *(u32x4*)(rowp + bj * 128) = w; } }
    }
};

struct Args { const float* in[22]; float* out; unsigned char* ws; int ph_lo, ph_hi; };
struct Frame {
    LAS unsigned char* lds; volatile LAS unsigned* MISC; unsigned* ctl;
    int tid, lane, wave, vcu, G, gw, NGW;
};

typedef const __attribute__((address_space(4))) Args CArgs;
struct ArgV { CArgs* p;
    __device__ __forceinline__ const float* in(int i) const { return p->in[i]; }
    __device__ __forceinline__ unsigned char* ws() const { return p->ws; }
    __device__ __forceinline__ float* out() const { return p->out; }
    __device__ __forceinline__ int ph_lo() const { return p->ph_lo; }
    __device__ __forceinline__ int ph_hi() const { return p->ph_hi; } };
__device__ __forceinline__ ArgV get_args() { CArgs* p = (CArgs*)__builtin_amdgcn_kernarg_segment_ptr(); asm volatile("" : "+s"(p)); ArgV a; a.p = p; return a; }
__device__ __forceinline__ void transpose_item(const float* src, int N, int k0, int n0, bf16_t* dst, int Kd, int drow0, LAS float* scr, int lane) {
#pragma unroll 4
    for (int i = 0; i < 16; ++i) { const int kk = 4 * i + (lane >> 4), c4 = (lane & 15) * 4;
        const f32x4 v = *(const f32x4*)(src + (size_t)(k0 + kk) * N + n0 + c4);
        LAS float* s = scr + kk * 65 + c4; s[0] = v[0]; s[1] = v[1]; s[2] = v[2]; s[3] = v[3]; }
    asm volatile("s_waitcnt lgkmcnt(0)" ::: "memory");
#pragma unroll 2
    for (int i = 0; i < 8; ++i) { const int cid = lane + 64 * i, n = cid >> 3, c = cid & 7; const LAS float* s = scr + (8 * c) * 65 + n;
        u32x4 o; o.x = pk2(s[0 * 65], s[1 * 65]); o.y = pk2(s[2 * 65], s[3 * 65]); o.z = pk2(s[4 * 65], s[5 * 65]); o.w = pk2(s[6 * 65], s[7 * 65]);
        *(u32x4*)(dst + (size_t)(drow0 + n) * Kd + k0 + 8 * c) = o; }
    asm volatile("s_waitcnt lgkmcnt(0)" ::: "memory");
}

__device__ __forceinline__ void phase_modpart(Frame& F, const float* c, const float* w_mod, float* modpart) {
    const int tid_ = fresh_tid(), lane_ = tid_ & 63; (void)tid_; (void)lane_;
    LAS float* red = (LAS float*)F.lds;
    for (int item = F.vcu; item < 256; item += F.G) {
        const int cg = item & 63, ks = item >> 6;
        const int cq = tid_ % 48, rg = tid_ / 48;
        float a[4][4];
#pragma unroll
        for (int b = 0; b < 4; ++b)
#pragma unroll
            for (int j = 0; j < 4; ++j) a[b][j] = 0.f;
        if (rg < 10) {
            for (int k = ks * 512 + rg; k < ks * 512 + 512; k += 10) {
                const f32x4 w = *(const f32x4*)(w_mod + (size_t)k * NMOD + cg * 192 + cq * 4);
#pragma unroll
                for (int b = 0; b < 4; ++b) { const float s = silu_f(c[b * DM + k]);
#pragma unroll
                    for (int j = 0; j < 4; ++j) a[b][j] += s * w[j]; }
            }
#pragma unroll
            for (int b = 0; b < 4; ++b)
#pragma unroll
                for (int j = 0; j < 4; ++j) red[(rg * 4 + b) * 192 + cq * 4 + j] = a[b][j];
        }
        __syncthreads();
        for (int o = tid_; o < 4 * 192; o += 512) { const int b = o / 192, col = o % 192; float s = 0.f;
            for (int r = 0; r < 10; ++r) s += red[(r * 4 + b) * 192 + col];
            modpart[((size_t)ks * 4 + b) * NMOD + cg * 192 + col] = s; }
        __syncthreads();
    }
}

__device__ __forceinline__ void phase_prep(Frame& F, const ArgV A) {
    const int tid_ = fresh_tid(), lane_ = tid_ & 63; (void)tid_; (void)lane_;
    const float* modpart = (const float*)(A.ws() + WS_MODPART); float* modv = (float*)(A.ws() + WS_MODV);
    const float *b_mod = A.in(3), *mod_layer = A.in(4), *norm1_g = A.in(5), *norm2_g = A.in(14);
    for (int idx = F.vcu * 512 + tid_; idx < NL * NB * 6 * DM; idx += F.G * 512) {
        const int col = idx % DM, which = (idx / DM) % 6, b = (idx / (6 * DM)) % NB, l = idx / (6 * DM * NB);
        const int n = which * DM + col;
        float m = b_mod[n] + mod_layer[l * NMOD + n];
#pragma unroll
        for (int ks = 0; ks < 4; ++ks) m += modpart[((size_t)ks * 4 + b) * NMOD + n];
        float o = m;
        if (which == 1) o = norm1_g[l * DM + col] * (1.f + m);
        if (which == 4) o = norm2_g[l * DM + col] * (1.f + m);
        modv[idx] = o;
    }
    {
        const float *w_group = A.in(15), *w_route = A.in(17); bf16_t* WrT = (bf16_t*)(A.ws() + WS_WRT);
        for (int idx = F.vcu * 512 + tid_; idx < NL * 64 * DM; idx += F.G * 512) {
            const int k = idx % DM, rho = (idx / DM) % 64, l = idx / (64 * DM);
            float val = 0.f;
            if (rho < 32) { const int h = (rho >> 2) & 1, rp = (rho & 3) + 4 * (rho >> 3), e = (2 * h + (rp >> 3)) * 8 + (rp & 7); val = w_route[((size_t)l * DM + k) * 32 + e]; }
            else if (rho < 40) val = w_group[((size_t)l * DM + k) * 4 + ((rho - 32) & 3)];
            WrT[idx] = (bf16_t)f2bf(val);
        }
    }
    LAS float* scr = (LAS float*)(F.lds + F.wave * 16640);
    constexpr int I_IN = NL * 32 * 40, I_OUT = NL * 16 * 32, I_GU = NL * NE * 2 * 32 * 4, I_DN = NL * NE * 4 * 32;
    const float *w_in = A.in(6), *w_out = A.in(13), *w_gate = A.in(19), *w_up = A.in(20), *w_down = A.in(21);
    bf16_t* WinT = (bf16_t*)(A.ws() + WS_WINT); bf16_t* WoutT = (bf16_t*)(A.ws() + WS_WOUTT); bf16_t* WguT = (bf16_t*)(A.ws() + WS_WGUT); bf16_t* WdT = (bf16_t*)(A.ws() + WS_WDT);
    for (int it = F.gw; it < I_IN + I_OUT + I_GU + I_DN; it += F.NGW) {
        int r = it;
        if (r < I_IN) { const int l = r / (32 * 40), q = r % (32 * 40), kb = q / 40, nb = q % 40;
            transpose_item(w_in + (size_t)l * DM * DIN, DIN, 64 * kb, 64 * nb, WinT + (size_t)l * DIN * DM, DM, 64 * nb, scr, lane_); continue; }
        r -= I_IN;
        if (r < I_OUT) { const int l = r / (16 * 32), q = r % (16 * 32), kb = q / 32, nb = q % 32;
            transpose_item(w_out + (size_t)l * DMIX * DM, DM, 64 * kb, 64 * nb, WoutT + (size_t)l * DM * DMIX, DMIX, 64 * nb, scr, lane_); continue; }
        r -= I_OUT;
        if (r < I_GU) { const int le = r / 256, q = r % 256, up = q >> 7, kb = (q & 127) >> 2, nb = q & 3;
            const float* src = (up ? w_up : w_gate) + (size_t)le * DM * DE;
            const int n0 = 64 * nb, drow0 = 256 * (n0 >> 7) + (n0 & 127) + 128 * up;
            transpose_item(src, DE, 64 * kb, n0, WguT + (size_t)le * 512 * DM, DM, drow0, scr, lane_); continue; }
        r -= I_GU;
        { const int le = r / 128, q = r % 128, kb = q >> 5, nb = q & 31;
            transpose_item(w_down + (size_t)le * DE * DM, DM, 64 * kb, 64 * nb, WdT + (size_t)le * DM * DE, DE, 64 * nb, scr, lane_); }
    }
}

__device__ __forceinline__ void build_tiles(Frame& F, int lc) {
    const int tid_ = fresh_tid(), lane_ = tid_ & 63; (void)tid_; (void)lane_;
    __syncthreads();
    if (tid_ < 32) { const unsigned n = __hip_atomic_load(F.ctl + CW_CNT + (lc * 32 + tid_) * 64, RLX_AGENT); F.MISC[64 + tid_] = n; }
    __syncthreads();
    if (tid_ == 0) { unsigned p = 0; for (int e = 0; e < 32; ++e) { F.MISC[16 + e] = p; p += (F.MISC[64 + e] + 255u) >> 8; } F.MISC[16 + 32] = p; }
    __syncthreads();
    if (tid_ < 32) { volatile LAS unsigned* te = (volatile LAS unsigned*)(F.lds + TILE_E_OFF); const unsigned a = F.MISC[16 + tid_], b = F.MISC[17 + tid_]; for (unsigned t = a; t < b; ++t) te[t] = (unsigned)tid_; }
    __syncthreads();
}

template <bool DO_NORM>
__device__ __forceinline__ void phase_norm1(Frame& F, const ArgV A, int l, bool combine, const float* x_src, float* x_dst, bool write_x) {
    const int tid_ = fresh_tid(), lane_ = tid_ & 63; (void)tid_; (void)lane_;
    const float* modv = (const float*)(A.ws() + WS_MODV);
    const bf16_t* yslot = (const bf16_t*)(A.ws() + WS_YSLOT); bf16_t* hout = (bf16_t*)(A.ws() + WS_H);
    const int* tok = (const int*)(A.ws() + WS_TOK);
    if (combine) build_tiles(F, l - 1);
    for (int blk = F.vcu; blk < NT / 128; blk += F.G) {
        const int b = (blk * 128) / SEQ;
        const float* mA_ = modv + ((size_t)((DO_NORM ? l : 0) * NB + b) * 6 + 1) * DM;
        const float* mS_ = modv + ((size_t)((DO_NORM ? l : 0) * NB + b) * 6 + 0) * DM;
        const float* mG_ = modv + ((size_t)((combine ? l - 1 : 0) * NB + b) * 6 + 5) * DM;
#pragma unroll 1
        for (int i = 0; i < 16; ++i) {
            const int row = blk * 128 + F.wave * 16 + i;
            const float *mA = mA_, *mS = mS_, *mG = mG_;
            asm volatile("" : "+s"(mA), "+s"(mS), "+s"(mG));
            const f32x4* xr = (const f32x4*)(x_src + (size_t)row * DM) + lane_;
            f32x4 v[8];
#pragma unroll
            for (int j = 0; j < 8; ++j) v[j] = xr[64 * j];
            if (combine) {
                const int e0 = tok[row * 8 + 0], e1 = tok[row * 8 + 1], p0 = tok[row * 8 + 2], p1 = tok[row * 8 + 3];
                const float w0 = __builtin_bit_cast(float, tok[row * 8 + 4]), w1 = __builtin_bit_cast(float, tok[row * 8 + 5]);
                const size_t s0 = (size_t)F.MISC[16 + e0] * 256 + p0, s1 = (size_t)F.MISC[16 + e1] * 256 + p1;
                const u32x2* y0 = (const u32x2*)(yslot + s0 * DM) + lane_; const u32x2* y1 = (const u32x2*)(yslot + s1 * DM) + lane_;
#pragma unroll
                for (int j = 0; j < 8; ++j) { const u32x2 a = y0[64 * j], c = y1[64 * j]; const f32x4 g = *((const f32x4*)mG + lane_ + 64 * j);
                    v[j][0] += g[0] * (w0 * bflo(a.x) + w1 * bflo(c.x)); v[j][1] += g[1] * (w0 * bfhi(a.x) + w1 * bfhi(c.x));
                    v[j][2] += g[2] * (w0 * bflo(a.y) + w1 * bflo(c.y)); v[j][3] += g[3] * (w0 * bfhi(a.y) + w1 * bfhi(c.y)); }
            }
            if (write_x) { f32x4* xo = (f32x4*)(x_dst + (size_t)row * DM) + lane_;
#pragma unroll
                for (int j = 0; j < 8; ++j) xo[64 * j] = v[j]; }
            if (DO_NORM) {
                float ss = 0.f;
#pragma unroll
                for (int j = 0; j < 8; ++j) ss += (v[j][0] * v[j][0] + v[j][1] * v[j][1]) + (v[j][2] * v[j][2] + v[j][3] * v[j][3]);
                const float rstd = 1.f / sqrtf(wave_sum(ss) * (1.f / DM) + EPS);
                u32x2* ho = (u32x2*)(hout + (size_t)row * DM) + lane_;
#pragma unroll
                for (int j = 0; j < 8; ++j) { const f32x4 a = *((const f32x4*)mA + lane_ + 64 * j), s = *((const f32x4*)mS + lane_ + 64 * j);
                    u32x2 o; o.x = pk2(v[j][0] * rstd * a[0] + s[0], v[j][1] * rstd * a[1] + s[1]); o.y = pk2(v[j][2] * rstd * a[2] + s[2], v[j][3] * rstd * a[3] + s[3]);
                    ho[64 * j] = o; }
            }
        }
    }
}

__device__ __forceinline__ void phase_gmlp(Frame& F, const ArgV A, int l) {
    const int tid_ = fresh_tid(), lane_ = tid_ & 63; (void)tid_; (void)lane_;
    const bf16_t* proj = (const bf16_t*)(A.ws() + WS_PROJ); bf16_t* ymix = (bf16_t*)(A.ws() + WS_YMIX);
    const float *gm_norm_g = A.in(7) + l * 512, *gm_ws = A.in(8) + (size_t)l * 4 * 128 * 128, *gm_bs = A.in(9) + l * 512, *out_norm_g = A.in(12) + l * DMIX;
    LAS float* vn = (LAS float*)F.lds;
    for (int u = F.vcu; u < NT / 128 * 4; u += F.G) {
        const int g = u & 3, ch = u >> 2, row0 = ch * 128;
        const int p = tid_ >> 2, seg = tid_ & 3;
        {
            const u32x4* vp = (const u32x4*)(proj + (size_t)(row0 + p) * DIN + 512 + g * 128 + seg * 32);
            float x[32]; float ss = 0.f;
#pragma unroll
            for (int c = 0; c < 4; ++c) { const u32x4 w = vp[c];
                x[c * 8 + 0] = bflo(w.x); x[c * 8 + 1] = bfhi(w.x); x[c * 8 + 2] = bflo(w.y); x[c * 8 + 3] = bfhi(w.y);
                x[c * 8 + 4] = bflo(w.z); x[c * 8 + 5] = bfhi(w.z); x[c * 8 + 6] = bflo(w.w); x[c * 8 + 7] = bfhi(w.w); }
#pragma unroll
            for (int j = 0; j < 32; ++j) { x[j] = gelu_exact(x[j]); ss += x[j] * x[j]; }
            ss += __shfl_xor(ss, 1); ss += __shfl_xor(ss, 2);
            const float rv = 1.f / sqrtf(ss * (1.f / 128.f) + EPS);
#pragma unroll
            for (int j = 0; j < 32; ++j) vn[p * 132 + seg * 32 + j] = x[j] * rv * gm_norm_g[g * 128 + seg * 32 + j];
        }
        __syncthreads();
        {
            const int t = p;
            float s[32];
#pragma unroll
            for (int j = 0; j < 32; ++j) s[j] = 0.f;
            const float* wrow = gm_ws + ((size_t)g * 128 + t) * 128;
            for (int pp = 0; pp <= t; ++pp) { const float w = wrow[pp]; const LAS f32x4* vr = (const LAS f32x4*)(vn + pp * 132 + seg * 32);
#pragma unroll
                for (int c = 0; c < 8; ++c) { const f32x4 q = vr[c]; s[c * 4 + 0] += w * q[0]; s[c * 4 + 1] += w * q[1]; s[c * 4 + 2] += w * q[2]; s[c * 4 + 3] += w * q[3]; } }
            const float bias = gm_bs[g * 128 + t];
            const u32x4* up = (const u32x4*)(proj + (size_t)(row0 + t) * DIN + g * 128 + seg * 32);
            float ss = 0.f;
#pragma unroll
            for (int c = 0; c < 4; ++c) { const u32x4 w = up[c]; float uu[8] = {bflo(w.x), bfhi(w.x), bflo(w.y), bfhi(w.y), bflo(w.z), bfhi(w.z), bflo(w.w), bfhi(w.w)};
#pragma unroll
                for (int j = 0; j < 8; ++j) { const float y = gelu_exact(uu[j]) * (s[c * 8 + j] + bias); s[c * 8 + j] = y; ss += y * y; } }
            ss += __shfl_xor(ss, 1); ss += __shfl_xor(ss, 2);
            const float ry = 1.f / sqrtf(ss * (1.f / 128.f) + EPS);
            u32x4* yo = (u32x4*)(ymix + (size_t)(row0 + t) * DMIX + g * 128 + seg * 32);
            const float* og = out_norm_g + g * 128 + seg * 32;
#pragma unroll
            for (int c = 0; c < 4; ++c) { u32x4 w;
                w.x = pk2(s[c * 8 + 0] * ry * og[c * 8 + 0], s[c * 8 + 1] * ry * og[c * 8 + 1]); w.y = pk2(s[c * 8 + 2] * ry * og[c * 8 + 2], s[c * 8 + 3] * ry * og[c * 8 + 3]);
                w.z = pk2(s[c * 8 + 4] * ry * og[c * 8 + 4], s[c * 8 + 5] * ry * og[c * 8 + 5]); w.w = pk2(s[c * 8 + 6] * ry * og[c * 8 + 6], s[c * 8 + 7] * ry * og[c * 8 + 7]);
                yo[c] = w; }
        }
        __syncthreads();
    }
}

__device__ __forceinline__ int crow(int r, int h) { return (r & 3) + 8 * (r >> 2) + 4 * h; }
__device__ __forceinline__ unsigned off_b(unsigned row, unsigned ch) { return 256u * row + 16u * (ch ^ (((row & 3u) << 2) | ((row >> 2) & 3u))); }
typedef short s16x4 __attribute__((ext_vector_type(4)));
__device__ __forceinline__ s16x4 vtr(const LAS unsigned char* p) { return __builtin_bit_cast(s16x4, __builtin_amdgcn_ds_read_tr16_b64_v4i16((LAS s16x4*)p)); }
__device__ __forceinline__ bf16x8 pack8(float a0, float a1, float a2, float a3, float a4, float a5, float a6, float a7) {
    u32x4 p; p.x = pk2(a0, a1); p.y = pk2(a2, a3); p.z = pk2(a4, a5); p.w = pk2(a6, a7); return __builtin_bit_cast(bf16x8, p); }
__device__ __forceinline__ void phase_attn(Frame& F, const ArgV A, int l) {
    const int tid_ = fresh_tid(), lane = tid_ & 63, r32 = lane & 31, hh = lane >> 5;
    const bf16_t* proj = (const bf16_t*)(A.ws() + WS_PROJ); bf16_t* ymix = (bf16_t*)(A.ws() + WS_YMIX); const float* ksq = (const float*)(A.ws() + WS_KSQ);
    const float *qg = A.in(10) + l * 128, *kg = A.in(11) + l * 128, *out_norm_g = A.in(12) + l * DMIX;
    LAS unsigned char* vimg = F.lds + F.wave * 8448;
    LAS float* rkbuf = (LAS float*)(vimg + 8192);
    const float c2 = 1.4426950408889634f * 0.08838834764831845f;
    bf16x8 tf[2];
#pragma unroll
    for (int s = 0; s < 2; ++s)
#pragma unroll
        for (int j = 0; j < 8; ++j) tf[s][j] = ((16 * s + 8 * (j >> 2) + 4 * hh + (j & 3)) >= r32) ? (short)0x3F80 : (short)0;
    const unsigned blk16 = (lane >> 4) & 1, tq = (lane & 15) >> 2, tp = lane & 3;
    for (int u = F.gw; u < NB * 4 * (SEQ / 32); u += F.NGW) {
        const int qb = u % (SEQ / 32), hd = (u / (SEQ / 32)) & 3, b = u / (4 * (SEQ / 32));
        const size_t rowq = (size_t)b * SEQ + qb * 32 + r32;
        bf16x8 qf[8];
        {
            const f32x4 qs4 = *(const f32x4*)(ksq + (rowq * 8 + hd) * 4);
            const float rq = c2 / sqrtf(((qs4[0] + qs4[1]) + (qs4[2] + qs4[3])) * (1.f / 128.f) + EPS);
            const u32x4* qp = (const u32x4*)(proj + rowq * DIN + 1024 + hd * 128 + 8 * hh);
#pragma unroll
            for (int s = 0; s < 8; ++s) { const u32x4 w = qp[2 * s]; const int d0 = 16 * s + 8 * hh;
                const f32x4 ga = *(const f32x4*)(qg + d0), gb = *(const f32x4*)(qg + d0 + 4), ka = *(const f32x4*)(kg + d0), kb = *(const f32x4*)(kg + d0 + 4);
                qf[s] = pack8(bflo(w.x) * rq * ga[0] * ka[0], bfhi(w.x) * rq * ga[1] * ka[1], bflo(w.y) * rq * ga[2] * ka[2], bfhi(w.y) * rq * ga[3] * ka[3],
                              bflo(w.z) * rq * gb[0] * kb[0], bfhi(w.z) * rq * gb[1] * kb[1], bflo(w.w) * rq * gb[2] * kb[2], bfhi(w.w) * rq * gb[3] * kb[3]); }
        }
        f32x16 o[4];
#pragma unroll
        for (int db = 0; db < 4; ++db)
#pragma unroll
            for (int q = 0; q < 16; ++q) o[db][q] = 0.f;
        float R = 0.f;
#pragma unroll 1
        for (int kt = qb; kt >= 0; --kt) {
            const size_t rowk0 = (size_t)b * SEQ + kt * 32;
            {
                u32x4 vv[8];
#pragma unroll
                for (int i = 0; i < 8; ++i) { const int c = lane + 64 * i; vv[i] = *(const u32x4*)(proj + (rowk0 + (c >> 4)) * DIN + 2048 + hd * 128 + 8 * (c & 15)); }
                float rkv = 0.f;
                if (lane < 32) { const f32x4 k4 = *(const f32x4*)(ksq + ((rowk0 + lane) * 8 + 4 + hd) * 4); rkv = 1.f / sqrtf(((k4[0] + k4[1]) + (k4[2] + k4[3])) * (1.f / 128.f) + EPS); }
#pragma unroll
                for (int i = 0; i < 8; ++i) { const int c = lane + 64 * i; *(LAS u32x4*)(vimg + off_b((unsigned)(c >> 4), (unsigned)(c & 15))) = vv[i]; }
                if (lane < 32) rkbuf[lane] = rkv;
                asm volatile("" ::: "memory");
            }
            bf16x8 kf[8];
            { const bf16x8* kp = (const bf16x8*)(proj + (rowk0 + r32) * DIN + 1536 + hd * 128 + 8 * hh);
#pragma unroll
              for (int s = 0; s < 8; ++s) kf[s] = kp[2 * s]; }
            f32x16 z;
#pragma unroll
            for (int q = 0; q < 16; ++q) z[q] = 0.f;
#pragma unroll
            for (int s = 0; s < 8; ++s) z = __builtin_amdgcn_mfma_f32_32x32x16_bf16(kf[s], qf[s], z, 0, 0, 0);
            f32x16 Lh;
            const bool diag = (kt == qb);
#pragma unroll
            for (int g = 0; g < 4; ++g) { const f32x4 rk4 = *(const LAS f32x4*)(rkbuf + 8 * g + 4 * hh);
#pragma unroll
                for (int e = 0; e < 4; ++e) { const int q = 4 * g + e; const float z2 = z[q] * rk4[e]; z[q] = z2;
                    const bool valid = !diag || (crow(q, hh) < r32);
                    Lh[q] = valid ? -__builtin_amdgcn_logf(1.f + __builtin_amdgcn_exp2f(z2)) : 0.f; } }
            f32x16 Y;
#pragma unroll
            for (int q = 0; q < 16; ++q) Y[q] = 0.f;
#pragma unroll
            for (int s = 0; s < 2; ++s) {
                const bf16x8 lhi = pack8(Lh[8 * s], Lh[8 * s + 1], Lh[8 * s + 2], Lh[8 * s + 3], Lh[8 * s + 4], Lh[8 * s + 5], Lh[8 * s + 6], Lh[8 * s + 7]);
                float lo[8];
#pragma unroll
                for (int j = 0; j < 8; ++j) lo[j] = Lh[8 * s + j] - __builtin_bit_cast(float, ((unsigned)(unsigned short)lhi[j]) << 16);
                const bf16x8 llo = pack8(lo[0], lo[1], lo[2], lo[3], lo[4], lo[5], lo[6], lo[7]);
                Y = __builtin_amdgcn_mfma_f32_32x32x16_bf16(tf[s], lhi, Y, 0, 0, 0);
                Y = __builtin_amdgcn_mfma_f32_32x32x16_bf16(tf[s], llo, Y, 0, 0, 0);
            }
#pragma unroll
            for (int q = 0; q < 16; ++q) { const bool valid = !diag || (crow(q, hh) < r32); const float a = __builtin_amdgcn_exp2f(z[q] + Y[q] + R); z[q] = valid ? a : 0.f; }
            R += __shfl(Y[0], r32);
#pragma unroll
            for (int s = 0; s < 2; ++s) {
                const bf16x8 pf = pack8(z[8 * s], z[8 * s + 1], z[8 * s + 2], z[8 * s + 3], z[8 * s + 4], z[8 * s + 5], z[8 * s + 6], z[8 * s + 7]);
#pragma unroll
                for (int db = 0; db < 4; ++db) {
                    const unsigned ra = (unsigned)(16 * s + 4 * hh) + tq, rb = ra + 8u;
                    const s16x4 lo4 = vtr(vimg + off_b(ra, 4u * db + 2u * blk16 + (tp >> 1)) + 8u * (tp & 1));
                    const s16x4 hi4 = vtr(vimg + off_b(rb, 4u * db + 2u * blk16 + (tp >> 1)) + 8u * (tp & 1));
                    const bf16x8 vf = __builtin_shufflevector(lo4, hi4, 0, 1, 2, 3, 4, 5, 6, 7);
                    o[db] = __builtin_amdgcn_mfma_f32_32x32x16_bf16(vf, pf, o[db], 0, 0, 0);
                }
            }
            if (__builtin_amdgcn_ballot_w64(R >= -150.f) == 0ull) break;
        }
        float ss = 0.f;
#pragma unroll
        for (int db = 0; db < 4; ++db)
#pragma unroll
            for (int q = 0; q < 16; ++q) ss += o[db][q] * o[db][q];
        ss += __shfl_xor(ss, 32);
        const float rs = 1.f / sqrtf(ss * (1.f / 128.f) + EPS);
        bf16_t* yo = ymix + rowq * DMIX + 512 + hd * 128;
        const float* og = out_norm_g + 512 + hd * 128;
#pragma unroll
        for (int db = 0; db < 4; ++db)
#pragma unroll
            for (int g = 0; g < 4; ++g) { const int d0 = 32 * db + 8 * g + 4 * hh; const f32x4 gg = *(const f32x4*)(og + d0);
                u32x2 w; w.x = pk2(o[db][4 * g] * rs * gg[0], o[db][4 * g + 1] * rs * gg[1]); w.y = pk2(o[db][4 * g + 2] * rs * gg[2], o[db][4 * g + 3] * rs * gg[3]);
                *(u32x2*)(yo + d0) = w; }
    }
}

__device__ __forceinline__ void phase_router(Frame& F, const ArgV A, int l, const float* x) {
    const int tid_ = fresh_tid(), lane = tid_ & 63;
    const float* modv = (const float*)(A.ws() + WS_MODV); bf16_t* hout = (bf16_t*)(A.ws() + WS_H);
    int* tok = (int*)(A.ws() + WS_TOK); int* list = (int*)(A.ws() + WS_LIST);
    const bf16_t* WrT = (const bf16_t*)(A.ws() + WS_WRT) + (size_t)l * 64 * DM;
    const float *b_group = A.in(16) + l * 4, *b_route = A.in(18) + l * 32;
    volatile LAS unsigned* lcnt = F.MISC + 128;
    for (int blk = F.vcu; blk < NT / 128; blk += F.G) {
        const int b = (blk * 128) / SEQ;
        const float* mA_ = modv + ((size_t)(l * NB + b) * 6 + 4) * DM; const float* mS_ = modv + ((size_t)(l * NB + b) * 6 + 3) * DM;
        if (tid_ < 64) lcnt[tid_] = 0u;
#pragma unroll 1
        for (int i = 0; i < 16; ++i) {
            const int row = blk * 128 + F.wave * 16 + i;
            const float *mA = mA_, *mS = mS_;
            asm volatile("" : "+s"(mA), "+s"(mS));
            const f32x4* xr = (const f32x4*)(x + (size_t)row * DM) + lane;
            f32x4 v[8]; float ss = 0.f;
#pragma unroll
            for (int j = 0; j < 8; ++j) { v[j] = xr[64 * j]; ss += (v[j][0] * v[j][0] + v[j][1] * v[j][1]) + (v[j][2] * v[j][2] + v[j][3] * v[j][3]); }
            const float rstd = 1.f / sqrtf(wave_sum(ss) * (1.f / DM) + EPS);
            u32x2* ho = (u32x2*)(hout + (size_t)row * DM) + lane;
#pragma unroll
            for (int j = 0; j < 8; ++j) { const f32x4 a = *((const f32x4*)mA + lane + 64 * j), s = *((const f32x4*)mS + lane + 64 * j);
                u32x2 o; o.x = pk2(v[j][0] * rstd * a[0] + s[0], v[j][1] * rstd * a[1] + s[1]); o.y = pk2(v[j][2] * rstd * a[2] + s[2], v[j][3] * rstd * a[3] + s[3]); ho[64 * j] = o; }
        }
        asm volatile("s_waitcnt vmcnt(0)" ::: "memory");
        __syncthreads();
        int e0 = 0, e1 = 0, lp0 = 0, lp1 = 0; float w0 = 0.f, w1 = 0.f; bool owner = false;
        const int r32 = lane & 31, hh = lane >> 5;
        const int myrow = blk * 128 + F.wave * 32 + r32;
        if (F.wave < 4) {
            f32x16 acc0, acc1;
#pragma unroll
            for (int q = 0; q < 16; ++q) { acc0[q] = 0.f; acc1[q] = 0.f; }
            const bf16x8* hb = (const bf16x8*)(hout + (size_t)myrow * DM + 8 * hh);
            const bf16x8* wa = (const bf16x8*)(WrT + (size_t)r32 * DM + 8 * hh);
            const bf16x8* wb = (const bf16x8*)(WrT + (size_t)(32 + r32) * DM + 8 * hh);
#pragma unroll 8
            for (int s = 0; s < 128; ++s) { const bf16x8 bv = hb[2 * s], a0 = wa[2 * s], a1 = wb[2 * s];
                acc0 = __builtin_amdgcn_mfma_f32_32x32x16_bf16(a0, bv, acc0, 0, 0, 0);
                acc1 = __builtin_amdgcn_mfma_f32_32x32x16_bf16(a1, bv, acc1, 0, 0, 0); }
            float gl[4];
#pragma unroll
            for (int q = 0; q < 4; ++q) gl[q] = acc1[q] + b_group[q];
            int gi = 0; float gm = gl[0];
#pragma unroll
            for (int q = 1; q < 4; ++q) if (gl[q] > gm) { gm = gl[q]; gi = q; }
            float den = 0.f;
#pragma unroll
            for (int q = 0; q < 4; ++q) den += __expf(gl[q] - gm);
            const float pg = 1.f / den;
            owner = ((gi >> 1) == hh);
            float ev[8];
#pragma unroll
            for (int q = 0; q < 8; ++q) ev[q] = ((gi & 1) ? acc0[8 + q] : acc0[q]) + b_route[(owner ? gi : 2 * hh) * 8 + q];
            int i0 = 0; float v0 = ev[0];
#pragma unroll
            for (int q = 1; q < 8; ++q) if (ev[q] > v0) { v0 = ev[q]; i0 = q; }
            int i1 = -1; float v1 = -3.0e38f;
#pragma unroll
            for (int q = 0; q < 8; ++q) if (q != i0 && ev[q] > v1) { v1 = ev[q]; i1 = q; }
            const float e1x = __expf(v1 - v0); w0 = pg / (1.f + e1x); w1 = pg * e1x / (1.f + e1x);
            e0 = gi * 8 + i0; e1 = gi * 8 + i1;
            if (owner) { lp0 = (int)__hip_atomic_fetch_add((LAS unsigned*)(lcnt + e0), 1u, __ATOMIC_RELAXED, __HIP_MEMORY_SCOPE_WORKGROUP);
                         lp1 = (int)__hip_atomic_fetch_add((LAS unsigned*)(lcnt + e1), 1u, __ATOMIC_RELAXED, __HIP_MEMORY_SCOPE_WORKGROUP); }
        }
        __syncthreads();
        if (tid_ < 32) { const unsigned n = lcnt[tid_]; unsigned base = 0u; if (n) base = atomicAdd(F.ctl + CW_CNT + (l * 32 + tid_) * 64, n); lcnt[32 + tid_] = base; }
        __syncthreads();
        if (owner) {
            const int p0 = (int)lcnt[32 + e0] + lp0, p1 = (int)lcnt[32 + e1] + lp1;
            list[(size_t)e0 * NT + p0] = myrow; list[(size_t)e1 * NT + p1] = myrow;
            tok[myrow * 8 + 0] = e0; tok[myrow * 8 + 1] = e1; tok[myrow * 8 + 2] = p0; tok[myrow * 8 + 3] = p1;
            tok[myrow * 8 + 4] = __builtin_bit_cast(int, w0); tok[myrow * 8 + 5] = __builtin_bit_cast(int, w1);
        }
        __syncthreads();
    }
}

__global__ void __launch_bounds__(512, 2) fwd_kernel(Args args_unused) {
    extern __shared__ __attribute__((aligned(16))) unsigned char lds_raw[];
    Frame F;
    F.lds = (LAS unsigned char*)lds_raw;
    F.MISC = (volatile LAS unsigned*)(F.lds + MISC_OFF);
    F.tid = threadIdx.x; F.lane = F.tid & 63; F.wave = __builtin_amdgcn_readfirstlane(F.tid >> 6);
    F.G = gridDim.x; { const int bx = blockIdx.x; F.vcu = (F.G % 8 == 0) ? (bx % 8) * (F.G / 8) + bx / 8 : bx; }
    F.gw = F.vcu * 8 + F.wave; F.NGW = F.G * 8;
    { const ArgV a0 = get_args(); F.ctl = (unsigned*)(a0.ws() + WS_CTL); }
    for (int u = F.tid; u < 256; u += 512) F.MISC[u] = 0u;
    __syncthreads();
    int lo, hi; { const ArgV a0 = get_args(); lo = a0.ph_lo(); hi = a0.ph_hi(); }
    XcdBarrier bar; bar.bar = F.ctl + CW_BAR; bar.x = 0; bar.st = nullptr;
    if (hi - lo > 1) bar = xcd_barrier_post(F.ctl + CW_BAR, F.MISC);
#ifndef PH_MASK
#define PH_MASK 0x1ff
#endif
#define PM(j) (((PH_MASK) >> (j)) & 1)
#define IN(k) (lo <= (k) && (k) < hi)
#define SEAM(k) do { if (IN(k) && IN((k) + 1)) xcd_barrier(bar); } while (0)
    if (PM(0) && IN(0)) { const ArgV args = get_args(); phase_modpart(F, args.in(1), args.in(2), (float*)(args.ws() + WS_MODPART)); } SEAM(0);
    if (PM(0) && IN(1)) { const ArgV args = get_args(); phase_prep(F, args); } SEAM(1);
    for (int l = 0; l < NL; ++l) {
        const int pb = 2 + 7 * l;
        if (PM(1) && IN(pb + 0)) { const ArgV args = get_args(); float* xres = args.out(); phase_norm1<true>(F, args, l, l > 0, l == 0 ? args.in(0) : xres, xres, true); } SEAM(pb + 0);
        if (PM(2) && IN(pb + 1)) {
            const ArgV args = get_args();
            DenseSched S; S.init(NT, DIN, DM, (const bf16_t*)(args.ws() + WS_WINT) + (size_t)l * DIN * DM, F.G, (int)blockIdx.x);
            EpiProj E{(bf16_t*)(args.ws() + WS_PROJ), (float*)(args.ws() + WS_KSQ)};
            pg8::gemm_phase<EpiProj, DenseSched>(F.lds, (const bf16_t*)(args.ws() + WS_H), DM, S, E);
        } SEAM(pb + 1);
        if (IN(pb + 2)) { if (PM(3)) { const ArgV args = get_args(); phase_gmlp(F, args, l); } if (PM(4)) { const ArgV args = get_args(); phase_attn(F, args, l); } } SEAM(pb + 2);
        if (PM(7) && IN(pb + 3)) {
            const ArgV args = get_args(); float* xres = args.out();
            DenseSched S; S.init(NT, DM, DMIX, (const bf16_t*)(args.ws() + WS_WOUTT) + (size_t)l * DM * DMIX, F.G, (int)blockIdx.x);
            EpiOut E{xres, (const float*)(args.ws() + WS_MODV) + ((size_t)(l * NB) * 6 + 2) * DM};
            pg8::gemm_phase<EpiOut, DenseSched>(F.lds, (const bf16_t*)(args.ws() + WS_YMIX), DMIX, S, E);
        } SEAM(pb + 3);
        if (PM(5) && IN(pb + 4)) { const ArgV args = get_args(); phase_router(F, args, l, args.out()); } SEAM(pb + 4);
        if (PM(6) && IN(pb + 5)) {
            const ArgV args = get_args();
            build_tiles(F, l);
            MoeSched<true> S; S.tp = F.MISC + 16; S.cnt = F.MISC + 64; S.te = (const volatile LAS unsigned*)(F.lds + TILE_E_OFF); S.list = (const int*)(args.ws() + WS_LIST);
            S.Bt = (const bf16_t*)(args.ws() + WS_WGUT) + (size_t)l * NE * 512 * DM; S.bstride_e = (size_t)512 * DM; S.K = DM; S.npn = 2; S.lognpn = 1; S.G = F.G; S.c = F.vcu;
            EpiAct E{(bf16_t*)(args.ws() + WS_ACT)};
            pg8::gemm_phase<EpiAct, MoeSched<true> >(F.lds, (const bf16_t*)(args.ws() + WS_H), DM, S, E);
        } SEAM(pb + 5);
        if (PM(8) && IN(pb + 6)) {
            const ArgV args = get_args();
            build_tiles(F, l);
            MoeSched<false> S; S.tp = F.MISC + 16; S.cnt = F.MISC + 64; S.te = (const volatile LAS unsigned*)(F.lds + TILE_E_OFF); S.list = nullptr;
            S.Bt = (const bf16_t*)(args.ws() + WS_WDT) + (size_t)l * NE * DM * DE; S.bstride_e = (size_t)DM * DE; S.K = DE; S.npn = 8; S.lognpn = 3; S.G = F.G; S.c = F.vcu;
            EpiY E{(bf16_t*)(args.ws() + WS_YSLOT)};
            pg8::gemm_phase<EpiY, MoeSched<false> >(F.lds, (const bf16_t*)(args.ws() + WS_ACT), DE, S, E);
        } SEAM(pb + 6);
    }
    if (PM(1) && IN(30)) { const ArgV args = get_args(); float* xres = args.out(); phase_norm1<false>(F, args, NL, true, xres, xres, true); }
#undef IN
#undef SEAM
}

extern "C" void kernel_launch(void* const* d_in, const int* in_sizes, int n_in, void* d_out, int out_size, void* d_ws, size_t ws_size, hipStream_t stream) {
    static int grid = 0;
    if (grid == 0) {
        if (n_in != 22 || out_size != NT * DM || ws_size < WS_END) { fprintf(stderr, "kernel_launch: unexpected problem (n_in %d out %d ws %zu)\n", n_in, out_size, ws_size); grid = -1; return; }
        int dev = 0, cus = 0;
        if (hipGetDevice(&dev) != hipSuccess || hipDeviceGetAttribute(&cus, hipDeviceAttributeMultiprocessorCount, dev) != hipSuccess) { grid = -1; return; }
        if (hipFuncSetAttribute((const void*)fwd_kernel, hipFuncAttributeMaxDynamicSharedMemorySize, LDS_BYTES) != hipSuccess) { fprintf(stderr, "kernel_launch: hipFuncSetAttribute failed\n"); grid = -1; return; }
        int per_cu = 0;
        (void)hipOccupancyMaxActiveBlocksPerMultiprocessor(&per_cu, (const void*)fwd_kernel, 512, LDS_BYTES);
        (void)hipGetLastError();
        grid = cus;
    }
    if (grid < 0) return;
    (void)hipMemsetAsync((char*)d_ws + WS_CTL, 0, CTL_ZERO_BYTES, stream);
    Args a{};
    for (int i = 0; i < 22; ++i) a.in[i] = (const float*)d_in[i];
    a.out = (float*)d_out; a.ws = (unsigned char*)d_ws;
#if MK_ONE_LAUNCH
    a.ph_lo = 0; a.ph_hi = NPHASE;
    hipLaunchKernelGGL(fwd_kernel, dim3(grid), dim3(512), LDS_BYTES, stream, a);
#else
    for (int p = 0; p < NPHASE; ++p) { a.ph_lo = p; a.ph_hi = p + 1; hipLaunchKernelGGL(fwd_kernel, dim3(grid), dim3(512), LDS_BYTES, stream, a); }
#endif
}
```

```cpp
#include <hip/hip_runtime.h>
#include <cstdio>
#include <cstdint>

#ifndef PROBE_KIND
#define PROBE_KIND -1
#endif
#ifndef MK_ONE_LAUNCH
#define MK_ONE_LAUNCH 1
#endif

#define LAS __attribute__((address_space(3)))
#define GAS __attribute__((address_space(1)))
typedef unsigned short bf16_t;
typedef short bf16x8 __attribute__((ext_vector_type(8)));
typedef float f32x4 __attribute__((ext_vector_type(4)));
typedef float f32x2 __attribute__((ext_vector_type(2)));
typedef float f32x16 __attribute__((ext_vector_type(16)));
typedef unsigned u32x4 __attribute__((ext_vector_type(4)));
typedef unsigned u32x2 __attribute__((ext_vector_type(2)));
typedef __bf16 bf16x2_t __attribute__((ext_vector_type(2)));

constexpr int DM = 2048, NB = 4, SEQ = 8192, NL = 4, NT = NB * SEQ;
constexpr int DIN = 2560, DMIX = 1024, NE = 32, DE = 256, NMOD = 6 * DM;
constexpr int SLOT_TILES = NT * 2 / 256 + NE, NSLOT = SLOT_TILES * 256;
constexpr float EPS = 1e-6f;
constexpr int NPHASE = 31;

constexpr size_t MiB = 1u << 20;
constexpr size_t WS_CTL = 0, CTL_ZERO_BYTES = 1 * MiB;
constexpr size_t WS_MODPART = 1 * MiB;
constexpr size_t WS_MODV = 2 * MiB;
constexpr size_t WS_TOK = 3 * MiB;
constexpr size_t WS_LIST = 4 * MiB;
constexpr size_t WS_KSQ = 8 * MiB;
constexpr size_t WS_WINT = 12 * MiB;
constexpr size_t WS_WOUTT = 52 * MiB;
constexpr size_t WS_WGUT = 68 * MiB;
constexpr size_t WS_WDT = 324 * MiB;
constexpr size_t WS_XB = 452 * MiB;
constexpr size_t WS_PROJ = 580 * MiB;
constexpr size_t WS_YMIX = 740 * MiB;
constexpr size_t WS_ACT = 804 * MiB;
constexpr size_t WS_YSLOT = 840 * MiB;
constexpr size_t WS_WRT = 1128 * MiB;
constexpr size_t WS_WGM = 1129 * MiB;
constexpr size_t WS_END = 1130 * MiB;
static_assert(WS_ACT + (size_t)NSLOT * 256 * 2 <= WS_YSLOT && WS_YSLOT + (size_t)NSLOT * 2048 * 2 <= WS_WRT, "ws map");
constexpr int CW_BAR = 4096;
constexpr int CW_CNT = 16384;

constexpr int LDS_BYTES = 147456;
constexpr int TILE_E_OFF = 131072;
constexpr int OFFN_OFF = 133120;
constexpr int MISC_OFF = 147456 - 1024;

#define RLX_AGENT __ATOMIC_RELAXED, __HIP_MEMORY_SCOPE_AGENT
__device__ __forceinline__ unsigned f2bf(float f) { unsigned u = __builtin_bit_cast(unsigned, f); return (u + 0x7fffu + ((u >> 16) & 1u)) >> 16; }
__device__ __forceinline__ unsigned pk2(float lo, float hi) { f32x2 v = {lo, hi}; bf16x2_t b = __builtin_convertvector(v, bf16x2_t); return __builtin_bit_cast(unsigned, b); }
__device__ __forceinline__ float bflo(unsigned u) { return __builtin_bit_cast(float, u << 16); }
__device__ __forceinline__ float bfhi(unsigned u) { return __builtin_bit_cast(float, u & 0xffff0000u); }
__device__ __forceinline__ float wave_sum(float v) {
#pragma unroll
    for (int o = 1; o < 64; o <<= 1) v += __shfl_xor(v, o);
    return v;
}
__device__ __forceinline__ int fresh_tid() { int t = threadIdx.x; asm volatile("" : "+v"(t)); return t; }
__device__ __forceinline__ float gelu_exact(float x) { return 0.5f * x * (1.f + erff(x * 0.70710678118654752f)); }
__device__ __forceinline__ float silu_f(float x) { return x / (1.f + __expf(-x)); }

#define XB_TMO      128
#define XB_XCNT(j)  (256  + 64 * (j))
#define XB_XSUB(j)  (1280 + 64 * (j))
#define XB_XGEN(j)  (2304 + 64 * (j))
#define XB_TOP      3328
#define XB_TOPGEN   3392
#define XCD_BAR_WORDS 3456
#define XB_SPIN_CAP (1u << 22)
__device__ __forceinline__ unsigned xb_ld(unsigned* p)              { return __hip_atomic_load(p, __ATOMIC_RELAXED, __HIP_MEMORY_SCOPE_AGENT); }
__device__ __forceinline__ unsigned xb_add(unsigned* p, unsigned v) { return __hip_atomic_fetch_add(p, v, __ATOMIC_RELAXED, __HIP_MEMORY_SCOPE_AGENT); }
__device__ __forceinline__ unsigned xb_xcc_id() { return (unsigned)__builtin_amdgcn_s_getreg((3 << 11) | 20) & 0xFu; }
#define XB_SPIN(cond, bar) do { unsigned _sp = 0; while (cond) { __builtin_amdgcn_s_sleep(1); \
    if ((++_sp & 255u) == 0u) { if (xb_ld(&(bar)[XB_TMO])) break; if (_sp > XB_SPIN_CAP) { atomicAdd(&(bar)[XB_TMO], 1u); break; } } } } while (0)
struct XcdBarrier { unsigned* bar; unsigned x; volatile LAS unsigned* st; };
__device__ __forceinline__ XcdBarrier xcd_barrier_post(unsigned* bar, volatile LAS unsigned* st) {
    XcdBarrier b; b.bar = bar; b.x = xb_xcc_id(); b.st = st;
    if (threadIdx.x == 0) (void)xb_add(&bar[XB_XCNT(b.x)], 1u);
    return b;
}
__device__ __forceinline__ void xcd_barrier_complete(unsigned* bar, unsigned x, unsigned& nloc, unsigned& nx) {
    const unsigned G = gridDim.x * gridDim.y * gridDim.z;
    unsigned sum, cnt, mine, sp = 0u;
    for (;;) {
        sum = 0u; cnt = 0u; mine = 0u;
#pragma unroll
        for (unsigned j = 0; j < 16; ++j) { const unsigned c = xb_ld(&bar[XB_XCNT(j)]); sum += c; cnt += (c > 0u) ? 1u : 0u; mine = (j == x) ? c : mine; }
        if (sum == G) break;
        __builtin_amdgcn_s_sleep(1);
        if ((++sp & 255u) == 0u) { if (xb_ld(&bar[XB_TMO])) break; if (sp > XB_SPIN_CAP) { atomicAdd(&bar[XB_TMO], 1u); break; } }
    }
    nloc = mine > 0u ? mine : 1u; nx = cnt > 0u ? cnt : 1u;
}
__device__ __forceinline__ void xcd_barrier(const XcdBarrier& b) {
    asm volatile("s_waitcnt vmcnt(0)" ::: "memory");
    __syncthreads();
    if (threadIdx.x == 0) {
        unsigned* bar = b.bar; unsigned bx = b.x;
        asm volatile("" : "+s"(bar), "+s"(bx));
        __builtin_amdgcn_s_waitcnt(0);
        unsigned nloc = b.st[0], nx = b.st[1];
        if (nloc == 0u) { xcd_barrier_complete(bar, bx, nloc, nx); b.st[0] = nloc; b.st[1] = nx; }
        const unsigned old = xb_add(&bar[XB_XSUB(bx)], 1u);
        const unsigned gen = old / nloc;
        if (old + 1u == (gen + 1u) * nloc) {
            __builtin_amdgcn_fence(__ATOMIC_RELEASE, "agent");
            asm volatile("s_waitcnt vmcnt(0)" ::: "memory");
            const unsigned og = xb_add(&bar[XB_TOP], 1u);
            const unsigned tg = og / nx;
            if (og + 1u == (tg + 1u) * nx) xb_add(&bar[XB_TOPGEN], 1u);
            else XB_SPIN(xb_ld(&bar[XB_TOPGEN]) == tg, bar);
            __builtin_amdgcn_fence(__ATOMIC_ACQUIRE, "agent");
            xb_add(&bar[XB_XGEN(bx)], 1u);
            asm volatile("s_waitcnt vmcnt(0)" ::: "memory");
        } else {
            XB_SPIN(xb_ld(&bar[XB_XGEN(bx)]) == gen, bar);
            __builtin_amdgcn_fence(__ATOMIC_ACQUIRE, "agent");
            asm volatile("s_waitcnt vmcnt(0)" ::: "memory");
        }
    }
    __syncthreads();
}

namespace pg8 {
constexpr int BM = 256, BK = 64, HALF = 128, HTB = HALF * BK * 2, NXCD = 8, WGM = 8;
__device__ __forceinline__ int lds_byte(int r, int c) { const int st = (r >> 4) * 2 + (c >> 5), rr = r & 15, cc = c & 31, ob = rr * 64 + cc * 2; return st * 1024 + (ob ^ (((ob >> 9) & 1) << 5)); }
__device__ __forceinline__ void stage_rc(int b, int& R, int& C) { const int st = b / 1024, sb = b % 1024, swz = sb ^ (((sb >> 9) & 1) << 5); R = (st >> 1) * 16 + swz / 64; C = (st & 1) * 32 + (swz % 64) / 2; }
__device__ __forceinline__ int perm32(int rho) { const int n = rho >> 4, i = rho & 15; return 8 * (i >> 2) + 4 * n + (i & 3); }

template <class Epi, class Sched>
__device__ __forceinline__ void gemm_phase(LAS unsigned char* lds, const bf16_t* Abase, const int K, const Sched& S, const Epi& E) {
    typedef typename Sched::Unit Unit;
    constexpr bool GATHER = Sched::GATHER;
    const int tid = fresh_tid(), wid = __builtin_amdgcn_readfirstlane(tid >> 6), lane = tid & 63, wr = wid >> 2, wc = wid & 3, fr = lane & 15, fq = lane >> 4;
    const int nt = K / BK;
    unsigned voffA[2], voffB[2];
#pragma unroll
    for (int i = 0; i < 2; ++i) { int R, C; stage_rc(tid * 16 + i * 8192, R, C); const int Rb = Epi::PERM ? ((R & ~31) + perm32(R & 31)) : R;
        voffA[i] = (unsigned)(R * K + C) * 2u; voffB[i] = (unsigned)(Rb * K + C) * 2u; }
    const size_t kstep = (size_t)(BK * 2);
    const size_t hstep = (size_t)HALF * K * 2;
    const unsigned ldsw0 = (unsigned)wid * 1024u; unsigned ldsw = ldsw0;
    const int aoff = lds_byte(wr * 64 + fr, fq * 8), boff = lds_byte(wc * 32 + fr, fq * 8);
    const char* Ab = (const char*)Abase;
#define PG8_SA(b, h) (((b) * 2 + (h)) * HTB)
#define PG8_SB(b, h) ((4 + (b) * 2 + (h)) * HTB)
#define PG8_STAGE(bufoff, gbase, voff) do { _Pragma("unroll") for (int _i = 0; _i < 2; ++_i) \
        __builtin_amdgcn_global_load_lds((const unsigned*)((const char*)(gbase) + (voff)[_i]), (LAS unsigned*)(lds + (bufoff) + ldsw + _i * 8192), 16, 0, 0); } while (0)
#define PG8_STAGEA(bufoff, p, kb, off, h) do { if constexpr (GATHER) { PG8_STAGE(bufoff, Ab + (kb), (off) + 2 * (h)); } else { PG8_STAGE(bufoff, (p) + (h) * hstep, voffA); } } while (0)
#define PG8_LDA(dst, b, h) do { _Pragma("unroll") for (int m = 0; m < 4; ++m) _Pragma("unroll") for (int k = 0; k < 2; ++k) dst[m][k] = *(const LAS bf16x8*)(lds + PG8_SA(b, h) + aoff + m * 2048 + k * 1024); } while (0)
#define PG8_LDB(dst, b, h) do { _Pragma("unroll") for (int n = 0; n < 2; ++n) _Pragma("unroll") for (int k = 0; k < 2; ++k) dst[n][k] = *(const LAS bf16x8*)(lds + PG8_SB(b, h) + boff + n * 2048 + k * 1024); } while (0)
#define PG8_MMA(ai, bj, At, Bt) do { __builtin_amdgcn_s_setprio(1); _Pragma("unroll") for (int m = 0; m < 4; ++m) _Pragma("unroll") for (int n = 0; n < 2; ++n) _Pragma("unroll") for (int k = 0; k < 2; ++k) \
        acc[ai][bj][m][n] = __builtin_amdgcn_mfma_f32_16x16x32_bf16(Bt[n][k], At[m][k], acc[ai][bj][m][n], 0, 0, 0); __builtin_amdgcn_s_setprio(0); } while (0)
#define PG8_WAIT_V(n) asm volatile("s_waitcnt vmcnt(" #n ")" ::: "memory")
#define PG8_WAIT_L(n) asm volatile("s_waitcnt lgkmcnt(" #n ")" ::: "memory")
#define PG8_BAR __builtin_amdgcn_s_barrier()
#define PG8_SCHED __builtin_amdgcn_sched_barrier(0)
#define PG8_AOFF(u, dst) do { _Pragma("unroll") for (int _h = 0; _h < 2; ++_h) _Pragma("unroll") for (int _i = 0; _i < 2; ++_i) { \
        int _R, _C; stage_rc(tid * 16 + _i * 8192, _R, _C); dst[_h * 2 + _i] = (S.arow(u, _h * HALF + _R) * (unsigned)K + (unsigned)_C) * 2u; } } while (0)
    Unit cur, nxt; int ui = 0;
    if (!S.next(0, cur)) return;
    f32x4 acc[2][2][4][2];
#pragma unroll
    for (int a = 0; a < 2; ++a)
#pragma unroll
        for (int b = 0; b < 2; ++b)
#pragma unroll
            for (int m = 0; m < 4; ++m)
#pragma unroll
                for (int n = 0; n < 2; ++n) acc[a][b][m][n] = (f32x4){0.f, 0.f, 0.f, 0.f};
    bf16x8 At[4][2], B0[2][2], B1[2][2];
    unsigned offc[4] = {0u, 0u, 0u, 0u}, offn[4] = {0u, 0u, 0u, 0u};
    volatile LAS unsigned* onx = (volatile LAS unsigned*)(lds + OFFN_OFF) + tid * 4;
    if constexpr (GATHER) PG8_AOFF(cur, offc);
    const char* cA = GATHER ? Ab : S.aptr(cur, Ab);
    const char* cB = S.bptr(cur);
    PG8_STAGE(PG8_SB(0, 0), cB, voffB); PG8_STAGE(PG8_SB(0, 1), cB + hstep, voffB); PG8_STAGEA(PG8_SA(0, 0), cA, 0, offc, 0); PG8_STAGEA(PG8_SA(0, 1), cA, 0, offc, 1);
    if (wr == 1) PG8_BAR;
    PG8_WAIT_V(2); PG8_BAR;
    PG8_STAGE(PG8_SB(1, 0), cB + kstep, voffB); PG8_STAGEA(PG8_SA(1, 0), cA + kstep, kstep, offc, 0); PG8_STAGE(PG8_SB(1, 1), cB + hstep + kstep, voffB);
    PG8_WAIT_V(6); PG8_BAR;
    for (;;) {
        const bool has_next = S.next(ui + 1, nxt);
        const char* nA = cA; const char* nB = cB;
        if (has_next) { nB = S.bptr(nxt); if constexpr (!GATHER) nA = S.aptr(nxt, Ab);
            if constexpr (GATHER) { unsigned tmp[4]; PG8_AOFF(nxt, tmp);
#pragma unroll
                for (int j = 0; j < 4; ++j) onx[j] = tmp[j]; } }
#pragma unroll 1
        for (int t = 0; t < nt; t += 2) {
            const bool last = (t == nt - 2);
            unsigned ldsw = ldsw0; asm volatile("" : "+s"(ldsw));
            const char* a1 = cA + (size_t)(t + 1) * kstep; const size_t k1 = (size_t)(t + 1) * kstep;
            const char* a2 = last ? nA : cA + (size_t)(t + 2) * kstep; const size_t k2 = last ? 0 : (size_t)(t + 2) * kstep;
            const char* b2 = last ? nB : cB + (size_t)(t + 2) * kstep;
            const char* a3 = a2 + kstep; const char* b3 = b2 + kstep; const size_t k3 = k2 + kstep;
            if constexpr (GATHER) {
#pragma unroll
                for (int j = 0; j < 4; ++j) offn[j] = offc[j];
                if (last && has_next) {
#pragma unroll
                    for (int j = 0; j < 4; ++j) offn[j] = onx[j];
                }
            }
            PG8_LDB(B0, 0, 0); PG8_LDB(B1, 0, 1); PG8_SCHED; PG8_LDA(At, 0, 0); PG8_STAGEA(PG8_SA(1, 1), a1, k1, offc, 1);
            PG8_WAIT_V(8); PG8_WAIT_L(0); PG8_BAR; PG8_MMA(0, 0, At, B0); PG8_MMA(0, 1, At, B1); PG8_BAR; PG8_SCHED;
            PG8_LDA(At, 0, 1); PG8_STAGE(PG8_SB(0, 0), b2, voffB); PG8_STAGE(PG8_SB(0, 1), b2 + hstep, voffB); PG8_STAGEA(PG8_SA(0, 0), a2, k2, offn, 0);
            PG8_WAIT_V(8); PG8_WAIT_L(0); PG8_BAR; PG8_MMA(1, 0, At, B0); PG8_MMA(1, 1, At, B1); PG8_BAR; PG8_SCHED;
            PG8_LDB(B0, 1, 0); PG8_LDB(B1, 1, 1); PG8_SCHED; PG8_LDA(At, 1, 0); PG8_STAGEA(PG8_SA(0, 1), a2, k2, offn, 1);
            PG8_WAIT_V(8); PG8_WAIT_L(0); PG8_BAR; PG8_MMA(0, 0, At, B0); PG8_MMA(0, 1, At, B1); PG8_BAR; PG8_SCHED;
            PG8_LDA(At, 1, 1); PG8_STAGE(PG8_SB(1, 0), b3, voffB); PG8_STAGE(PG8_SB(1, 1), b3 + hstep, voffB); PG8_STAGEA(PG8_SA(1, 0), a3, k3, offn, 0);
            PG8_WAIT_V(8); PG8_WAIT_L(0); PG8_BAR; PG8_MMA(1, 0, At, B0); PG8_MMA(1, 1, At, B1); PG8_BAR; PG8_SCHED;
        }
        if (wr == 0) PG8_BAR;
        E(acc, cur, wr, wc, fr, fq);
        if (!has_next) break;
#pragma unroll
        for (int a = 0; a < 2; ++a)
#pragma unroll
            for (int b = 0; b < 2; ++b)
#pragma unroll
                for (int m = 0; m < 4; ++m)
#pragma unroll
                    for (int n = 0; n < 2; ++n) acc[a][b][m][n] = (f32x4){0.f, 0.f, 0.f, 0.f};
        cur = nxt; cA = nA; cB = nB; ++ui;
        if constexpr (GATHER) {
#pragma unroll
            for (int j = 0; j < 4; ++j) offc[j] = onx[j];
        }
        if (wr == 1) PG8_BAR;
    }
    PG8_WAIT_V(0);
    PG8_BAR;
#undef PG8_SA
#undef PG8_SB
#undef PG8_STAGE
#undef PG8_STAGEA
#undef PG8_LDA
#undef PG8_LDB
#undef PG8_MMA
#undef PG8_WAIT_V
#undef PG8_WAIT_L
#undef PG8_BAR
#undef PG8_SCHED
#undef PG8_AOFF
}
}

struct DenseUnit { int pm, pn; };
struct DenseSched {
    typedef DenseUnit Unit;
    int nM, nN, nwg, G, c; const bf16_t* Bt; int K;
    __device__ __forceinline__ void init(int M, int N, int K_, const bf16_t* Bt_, int G_, int c_) { nM = M / 256; nN = N / 256; nwg = nM * nN; G = G_; c = c_; Bt = Bt_; K = K_; }
    __device__ __forceinline__ bool next(int i, Unit& u) const {
        const long L = (long)i * G + c; if (L >= nwg) return false;
        int wgid = (int)L; { const int q = nwg / 8, r = nwg % 8, xcd = wgid % 8, off = wgid / 8; wgid = (xcd < r ? xcd * (q + 1) : r * (q + 1) + (xcd - r) * q) + off; }
        const int nig = 8 * nN, gid = wgid / nig, fm = gid * 8, gsz = (nM - fm) < 8 ? (nM - fm) : 8;
        u.pm = fm + ((wgid % nig) % gsz); u.pn = (wgid % nig) / gsz; return true;
    }
    static constexpr bool GATHER = false;
    __device__ __forceinline__ unsigned arow(const Unit& u, int r) const { return (unsigned)(u.pm * 256 + r); }
    __device__ __forceinline__ const char* aptr(const Unit& u, const char* Ab) const { return Ab + (size_t)u.pm * 256 * K * 2; }
    __device__ __forceinline__ const char* bptr(const Unit& u) const { return (const char*)(Bt + (size_t)u.pn * 256 * K); }
};
struct MoeUnit { int e, tile, rt, pn, cnt; };
template <bool GATHER_>
struct MoeSched {
    typedef MoeUnit Unit;
    static constexpr bool GATHER = GATHER_;
    const volatile LAS unsigned* tp;
    const volatile LAS unsigned* cnt;
    const volatile LAS unsigned* te;
    const int* list;
    const bf16_t* Bt; size_t bstride_e; int K; int npn, lognpn; int G, c;
    __device__ __forceinline__ bool next(int i, Unit& u) const {
        const int L = i * G + c; const int tile = L >> lognpn; const int ntile = __builtin_amdgcn_readfirstlane((int)tp[32]);
        if (tile >= ntile) return false;
        u.e = __builtin_amdgcn_readfirstlane((int)te[tile]); u.tile = tile; u.rt = tile - __builtin_amdgcn_readfirstlane((int)tp[u.e]);
        u.cnt = __builtin_amdgcn_readfirstlane((int)cnt[u.e]); u.pn = L & (npn - 1); return true;
    }
    __device__ __forceinline__ const char* aptr(const Unit& u, const char* Ab) const { return Ab + (size_t)u.tile * 256 * K * 2; }
    __device__ __forceinline__ unsigned arow(const Unit& u, int r) const {
        const int slot = u.rt * 256 + r;
        return (slot < u.cnt) ? (unsigned)list[(size_t)u.e * NT + slot] : 0u;
    }
    __device__ __forceinline__ const char* bptr(const Unit& u) const { return (const char*)(Bt + (size_t)u.e * bstride_e + (size_t)u.pn * 256 * K); }
};

struct EpiProj {
    static constexpr bool PERM = true;
    bf16_t* O; float* ksq;
    __device__ __forceinline__ void operator()(const f32x4 (&acc)[2][2][4][2], const DenseUnit& u, int wr, int wc, int fr, int fq) const {
        const int row0 = u.pm * 256 + wr * 64 + fr, col0 = u.pn * 256 + wc * 32 + 8 * fq;
        const bool qk = (u.pn >= 4 && u.pn < 8);
#pragma unroll
        for (int ai = 0; ai < 2; ++ai)
#pragma unroll
            for (int m = 0; m < 4; ++m) { const int row = row0 + ai * 128 + m * 16; bf16_t* rowp = O + (size_t)row * DIN + col0;
#pragma unroll
                for (int bj = 0; bj < 2; ++bj) { const f32x4 v0 = acc[ai][bj][m][0], v1 = acc[ai][bj][m][1];
                    u32x4 w; w.x = pk2(v0[0], v0[1]); w.y = pk2(v0[2], v0[3]); w.z = pk2(v1[0], v1[1]); w.w = pk2(v1[2], v1[3]);
                    *(u32x4*)(rowp + bj * 128) = w;
                    if (qk) { float ss = (v0[0] * v0[0] + v0[1] * v0[1]) + (v0[2] * v0[2] + v0[3] * v0[3]) + (v1[0] * v1[0] + v1[1] * v1[1]) + (v1[2] * v1[2] + v1[3] * v1[3]);
                        ss += __shfl_xor(ss, 16); ss += __shfl_xor(ss, 32);
                        if (fq == 0) ksq[((size_t)row * 8 + (u.pn - 4) * 2 + bj) * 4 + wc] = ss; } } }
    }
};
struct EpiOut {
    static constexpr bool PERM = true;
    bf16_t* X; const float* gate;
    __device__ __forceinline__ void operator()(const f32x4 (&acc)[2][2][4][2], const DenseUnit& u, int wr, int wc, int fr, int fq) const {
        const int row0 = u.pm * 256 + wr * 64 + fr, col0 = u.pn * 256 + wc * 32 + 8 * fq;
        const int b = (u.pm * 256) / SEQ;
        f32x4 gv[2][2];
#pragma unroll
        for (int bj = 0; bj < 2; ++bj)
#pragma unroll
            for (int n = 0; n < 2; ++n) gv[bj][n] = *(const f32x4*)(gate + (size_t)b * 6 * DM + col0 + bj * 128 + n * 4);
#pragma unroll
        for (int ai = 0; ai < 2; ++ai)
#pragma unroll
            for (int m = 0; m < 4; ++m) { bf16_t* rowp = X + (size_t)(row0 + ai * 128 + m * 16) * DM + col0;
#pragma unroll
                for (int bj = 0; bj < 2; ++bj) { u32x4* p = (u32x4*)(rowp + bj * 128); const u32x4 w = *p;
                    const f32x4 a0 = gv[bj][0] * acc[ai][bj][m][0], a1 = gv[bj][1] * acc[ai][bj][m][1];
                    u32x4 o; o.x = pk2(bflo(w.x) + a0[0], bfhi(w.x) + a0[1]); o.y = pk2(bflo(w.y) + a0[2], bfhi(w.y) + a0[3]);
                    o.z = pk2(bflo(w.z) + a1[0], bfhi(w.z) + a1[1]); o.w = pk2(bflo(w.w) + a1[2], bfhi(w.w) + a1[3]); *p = o; }
                asm volatile("" ::: "memory"); }
    }
};
struct EpiAct {
    static constexpr bool PERM = true;
    bf16_t* O;
    __device__ __forceinline__ void operator()(const f32x4 (&acc)[2][2][4][2], const MoeUnit& u, int wr, int wc, int fr, int fq) const {
        const int row0 = u.tile * 256 + wr * 64 + fr, col0 = u.pn * 128 + wc * 32 + 8 * fq;
#pragma unroll
        for (int ai = 0; ai < 2; ++ai)
#pragma unroll
            for (int m = 0; m < 4; ++m) { bf16_t* rowp = O + (size_t)(row0 + ai * 128 + m * 16) * DE + col0;
                float r[8];
#pragma unroll
                for (int n = 0; n < 2; ++n)
#pragma unroll
                    for (int j = 0; j < 4; ++j) r[n * 4 + j] = silu_f(acc[ai][0][m][n][j]) * acc[ai][1][m][n][j];
                u32x4 w; w.x = pk2(r[0], r[1]); w.y = pk2(r[2], r[3]); w.z = pk2(r[4], r[5]); w.w = pk2(r[6], r[7]);
                *(u32x4*)rowp = w; }
    }
};
struct EpiY {
    static constexpr bool PERM = true;
    bf16_t* O;
    __device__ __forceinline__ void operator()(const f32x4 (&acc)[2][2][4][2], const MoeUnit& u, int wr, int wc, int fr, int fq) const {
        const int row0 = u.tile * 256 + wr * 64 + fr, col0 = u.pn * 256 + wc * 32 + 8 * fq;
#pragma unroll
        for (int ai = 0; ai < 2; ++ai)
#pragma unroll
            for (int m = 0; m < 4; ++m) { bf16_t* rowp = O + (size_t)(row0 + ai * 128 + m * 16) * DM + col0;
#pragma unroll
                for (int bj = 0; bj < 2; ++bj) { const f32x4 v0 = acc[ai][bj][m][0], v1 = acc[ai][bj][m][1];
                    u32x4 w; w.x = pk2(v0[0], v0[1]); w.y = pk2(v0[2], v0[3]); w.z = pk2(v1[0], v1[1]); w.w = pk2(v1[2], v1[3]);
                    *(u32x4*)(rowp + bj * 128) = w; } }
    }
};

struct Args { const float* in[22]; float* out; unsigned char* ws; int ph_lo, ph_hi; };
struct Frame {
    LAS unsigned char* lds; volatile LAS unsigned* MISC; unsigned* ctl;
    int tid, lane, wave, vcu, G, gw, NGW;
};

typedef const __attribute__((address_space(4))) Args CArgs;
struct ArgV { CArgs* p;
    __device__ __forceinline__ const float* in(int i) const { return p->in[i]; }
    __device__ __forceinline__ unsigned char* ws() const { return p->ws; }
    __device__ __forceinline__ float* out() const { return p->out; }
    __device__ __forceinline__ int ph_lo() const { return p->ph_lo; }
    __device__ __forceinline__ int ph_hi() const { return p->ph_hi; } };
__device__ __forceinline__ ArgV get_args() { CArgs* p = (CArgs*)__builtin_amdgcn_kernarg_segment_ptr(); asm volatile("" : "+s"(p)); ArgV a; a.p = p; return a; }
__device__ __forceinline__ void transpose_item(const float* src, int N, int k0, int n0, bf16_t* dst, int Kd, int drow0, LAS float* scr, int lane) {
#pragma unroll 4
    for (int i = 0; i < 16; ++i) { const int kk = 4 * i + (lane >> 4), c4 = (lane & 15) * 4;
        const f32x4 v = *(const f32x4*)(src + (size_t)(k0 + kk) * N + n0 + c4);
        LAS float* s = scr + kk * 65 + c4; s[0] = v[0]; s[1] = v[1]; s[2] = v[2]; s[3] = v[3]; }
    asm volatile("s_waitcnt lgkmcnt(0)" ::: "memory");
#pragma unroll 2
    for (int i = 0; i < 8; ++i) { const int cid = lane + 64 * i, n = cid >> 3, c = cid & 7; const LAS float* s = scr + (8 * c) * 65 + n;
        u32x4 o; o.x = pk2(s[0 * 65], s[1 * 65]); o.y = pk2(s[2 * 65], s[3 * 65]); o.z = pk2(s[4 * 65], s[5 * 65]); o.w = pk2(s[6 * 65], s[7 * 65]);
        *(u32x4*)(dst + (size_t)(drow0 + n) * Kd + k0 + 8 * c) = o; }
    asm volatile("s_waitcnt lgkmcnt(0)" ::: "memory");
}

__device__ __forceinline__ void phase_modpart(Frame& F, const float* c, const float* w_mod, float* modpart) {
    int vcu_ = F.vcu, gw_ = F.gw; asm volatile("" : "+s"(vcu_), "+s"(gw_)); (void)vcu_; (void)gw_;
    const int tid_ = fresh_tid(), lane_ = tid_ & 63; (void)tid_; (void)lane_;
    LAS float* red = (LAS float*)F.lds;
    for (int item = vcu_; item < 256; item += F.G) {
        const int cg = item & 63, ks = item >> 6;
        const int cq = tid_ % 48, rg = tid_ / 48;
        float a[4][4];
#pragma unroll
        for (int b = 0; b < 4; ++b)
#pragma unroll
            for (int j = 0; j < 4; ++j) a[b][j] = 0.f;
        if (rg < 10) {
            for (int k = ks * 512 + rg; k < ks * 512 + 512; k += 10) {
                const f32x4 w = *(const f32x4*)(w_mod + (size_t)k * NMOD + cg * 192 + cq * 4);
#pragma unroll
                for (int b = 0; b < 4; ++b) { const float s = silu_f(c[b * DM + k]);
#pragma unroll
                    for (int j = 0; j < 4; ++j) a[b][j] += s * w[j]; }
            }
#pragma unroll
            for (int b = 0; b < 4; ++b)
#pragma unroll
                for (int j = 0; j < 4; ++j) red[(rg * 4 + b) * 192 + cq * 4 + j] = a[b][j];
        }
        __syncthreads();
        for (int o = tid_; o < 4 * 192; o += 512) { const int b = o / 192, col = o % 192; float s = 0.f;
            for (int r = 0; r < 10; ++r) s += red[(r * 4 + b) * 192 + col];
            modpart[((size_t)ks * 4 + b) * NMOD + cg * 192 + col] = s; }
        __syncthreads();
    }
}

__device__ __forceinline__ void phase_prep(Frame& F, const ArgV A) {
    int vcu_ = F.vcu, gw_ = F.gw; asm volatile("" : "+s"(vcu_), "+s"(gw_)); (void)vcu_; (void)gw_;
    const int tid_ = fresh_tid(), lane_ = tid_ & 63; (void)tid_; (void)lane_;
    const float* modpart = (const float*)(A.ws() + WS_MODPART); float* modv = (float*)(A.ws() + WS_MODV);
    const float *b_mod = A.in(3), *mod_layer = A.in(4), *norm1_g = A.in(5), *norm2_g = A.in(14);
    for (int idx = vcu_ * 512 + tid_; idx < NL * NB * 6 * DM; idx += F.G * 512) {
        const int col = idx % DM, which = (idx / DM) % 6, b = (idx / (6 * DM)) % NB, l = idx / (6 * DM * NB);
        const int n = which * DM + col;
        float m = b_mod[n] + mod_layer[l * NMOD + n];
#pragma unroll
        for (int ks = 0; ks < 4; ++ks) m += modpart[((size_t)ks * 4 + b) * NMOD + n];
        float o = m;
        if (which == 1) o = norm1_g[l * DM + col] * (1.f + m);
        if (which == 4) o = norm2_g[l * DM + col] * (1.f + m);
        modv[idx] = o;
    }
    {
        const float *w_group = A.in(15), *w_route = A.in(17); bf16_t* WrT = (bf16_t*)(A.ws() + WS_WRT);
        for (int idx = vcu_ * 512 + tid_; idx < NL * 64 * DM; idx += F.G * 512) {
            const int k = idx % DM, rho = (idx / DM) % 64, l = idx / (64 * DM);
            float val = 0.f;
            if (rho < 32) { const int h = (rho >> 2) & 1, rp = (rho & 3) + 4 * (rho >> 3), e = (2 * h + (rp >> 3)) * 8 + (rp & 7); val = w_route[((size_t)l * DM + k) * 32 + e]; }
            else if (rho < 40) val = w_group[((size_t)l * DM + k) * 4 + ((rho - 32) & 3)];
            WrT[idx] = (bf16_t)f2bf(val);
        }
    }
    {
        const float* gm_ws = A.in(8); bf16_t* Wgm = (bf16_t*)(A.ws() + WS_WGM);
        for (int idx = vcu_ * 512 + tid_; idx < NL * 4 * 128 * 128; idx += F.G * 512) { const int p = idx & 127, t = (idx >> 7) & 127; Wgm[idx] = (p <= t) ? (bf16_t)f2bf(gm_ws[idx]) : (bf16_t)0; }
    }
    LAS float* scr = (LAS float*)(F.lds + F.wave * 16640);
    constexpr int I_IN = NL * 32 * 40, I_OUT = NL * 16 * 32, I_GU = NL * NE * 2 * 32 * 4, I_DN = NL * NE * 4 * 32;
    const float *w_in = A.in(6), *w_out = A.in(13), *w_gate = A.in(19), *w_up = A.in(20), *w_down = A.in(21);
    bf16_t* WinT = (bf16_t*)(A.ws() + WS_WINT); bf16_t* WoutT = (bf16_t*)(A.ws() + WS_WOUTT); bf16_t* WguT = (bf16_t*)(A.ws() + WS_WGUT); bf16_t* WdT = (bf16_t*)(A.ws() + WS_WDT);
    for (int it = gw_; it < I_IN + I_OUT + I_GU + I_DN; it += F.NGW) {
        int r = it;
        if (r < I_IN) { const int l = r / (32 * 40), q = r % (32 * 40), kb = q / 40, nb = q % 40;
            transpose_item(w_in + (size_t)l * DM * DIN, DIN, 64 * kb, 64 * nb, WinT + (size_t)l * DIN * DM, DM, 64 * nb, scr, lane_); continue; }
        r -= I_IN;
        if (r < I_OUT) { const int l = r / (16 * 32), q = r % (16 * 32), kb = q / 32, nb = q % 32;
            transpose_item(w_out + (size_t)l * DMIX * DM, DM, 64 * kb, 64 * nb, WoutT + (size_t)l * DM * DMIX, DMIX, 64 * nb, scr, lane_); continue; }
        r -= I_OUT;
        if (r < I_GU) { const int le = r / 256, q = r % 256, up = q >> 7, kb = (q & 127) >> 2, nb = q & 3;
            const float* src = (up ? w_up : w_gate) + (size_t)le * DM * DE;
            const int n0 = 64 * nb, drow0 = 256 * (n0 >> 7) + (n0 & 127) + 128 * up;
            transpose_item(src, DE, 64 * kb, n0, WguT + (size_t)le * 512 * DM, DM, drow0, scr, lane_); continue; }
        r -= I_GU;
        { const int le = r / 128, q = r % 128, kb = q >> 5, nb = q & 31;
            transpose_item(w_down + (size_t)le * DE * DM, DM, 64 * kb, 64 * nb, WdT + (size_t)le * DM * DE, DE, 64 * nb, scr, lane_); }
    }
}

__device__ __forceinline__ void build_tiles(Frame& F, int lc) {
    const int tid_ = fresh_tid(), lane_ = tid_ & 63; (void)tid_; (void)lane_;
    __syncthreads();
    if (tid_ < 32) { const unsigned n = __hip_atomic_load(F.ctl + CW_CNT + (lc * 32 + tid_) * 64, RLX_AGENT); F.MISC[64 + tid_] = n; }
    __syncthreads();
    if (tid_ == 0) { unsigned p = 0; for (int e = 0; e < 32; ++e) { F.MISC[16 + e] = p; p += (F.MISC[64 + e] + 255u) >> 8; } F.MISC[16 + 32] = p; }
    __syncthreads();
    if (tid_ < 32) { volatile LAS unsigned* te = (volatile LAS unsigned*)(F.lds + TILE_E_OFF); const unsigned a = F.MISC[16 + tid_], b = F.MISC[17 + tid_]; for (unsigned t = a; t < b; ++t) te[t] = (unsigned)tid_; }
    __syncthreads();
}

template <int MODE>
__device__ __forceinline__ void phase_norm1(Frame& F, const ArgV A, int l) {
    int vcu_ = F.vcu, gw_ = F.gw; asm volatile("" : "+s"(vcu_), "+s"(gw_)); (void)vcu_; (void)gw_;
    const int tid_ = fresh_tid(), lane_ = tid_ & 63; (void)tid_;
    const float* modv = (const float*)(A.ws() + WS_MODV);
    const bf16_t* yslot = (const bf16_t*)(A.ws() + WS_YSLOT); bf16_t* hout = (bf16_t*)A.out(); bf16_t* xb = (bf16_t*)(A.ws() + WS_XB);
    const float* xin = A.in(0); float* outf = A.out();
    const int* tok = (const int*)(A.ws() + WS_TOK);
    if (MODE != 0) build_tiles(F, l - 1);
    for (int blk = vcu_; blk < NT / 128; blk += F.G) {
        const int b = (blk * 128) / SEQ;
        const float* mA_ = modv + ((size_t)((MODE != 2 ? l : 0) * NB + b) * 6 + 1) * DM;
        const float* mS_ = modv + ((size_t)((MODE != 2 ? l : 0) * NB + b) * 6 + 0) * DM;
        const float* mG_ = modv + ((size_t)((MODE != 0 ? l - 1 : 0) * NB + b) * 6 + 5) * DM;
#pragma unroll 1
        for (int i = 0; i < 16; ++i) {
            const int row = blk * 128 + F.wave * 16 + i;
            const float *mA = mA_, *mS = mS_, *mG = mG_;
            asm volatile("" : "+s"(mA), "+s"(mS), "+s"(mG));
            f32x4 v[8];
            if (MODE == 0) { const f32x4* xr = (const f32x4*)(xin + (size_t)row * DM) + lane_;
#pragma unroll
                for (int j = 0; j < 8; ++j) v[j] = xr[64 * j]; }
            else { const u32x2* xr = (const u32x2*)(xb + (size_t)row * DM) + lane_;
#pragma unroll
                for (int j = 0; j < 8; ++j) { const u32x2 w = xr[64 * j]; v[j] = (f32x4){bflo(w.x), bfhi(w.x), bflo(w.y), bfhi(w.y)}; } }
            if (MODE != 0) {
                const int e0 = tok[row * 8 + 0], e1 = tok[row * 8 + 1], p0 = tok[row * 8 + 2], p1 = tok[row * 8 + 3];
                const float w0 = __builtin_bit_cast(float, tok[row * 8 + 4]), w1 = __builtin_bit_cast(float, tok[row * 8 + 5]);
                const size_t s0 = (size_t)F.MISC[16 + e0] * 256 + p0, s1 = (size_t)F.MISC[16 + e1] * 256 + p1;
                const u32x2* y0 = (const u32x2*)(yslot + s0 * DM) + lane_; const u32x2* y1 = (const u32x2*)(yslot + s1 * DM) + lane_;
#pragma unroll
                for (int j = 0; j < 8; ++j) { const u32x2 a = y0[64 * j], c = y1[64 * j]; const f32x4 g = *((const f32x4*)mG + lane_ + 64 * j);
                    v[j][0] += g[0] * (w0 * bflo(a.x) + w1 * bflo(c.x)); v[j][1] += g[1] * (w0 * bfhi(a.x) + w1 * bfhi(c.x));
                    v[j][2] += g[2] * (w0 * bflo(a.y) + w1 * bflo(c.y)); v[j][3] += g[3] * (w0 * bfhi(a.y) + w1 * bfhi(c.y)); }
            }
            if (MODE == 2) { f32x4* xo = (f32x4*)(outf + (size_t)row * DM) + lane_;
#pragma unroll
                for (int j = 0; j < 8; ++j) xo[64 * j] = v[j]; }
            else {
                u32x2* xo = (u32x2*)(xb + (size_t)row * DM) + lane_;
                float ss = 0.f;
#pragma unroll
                for (int j = 0; j < 8; ++j) { u32x2 o; o.x = pk2(v[j][0], v[j][1]); o.y = pk2(v[j][2], v[j][3]); xo[64 * j] = o;
                    v[j] = (f32x4){bflo(o.x), bfhi(o.x), bflo(o.y), bfhi(o.y)};
                    ss += (v[j][0] * v[j][0] + v[j][1] * v[j][1]) + (v[j][2] * v[j][2] + v[j][3] * v[j][3]); }
                const float rstd = 1.f / sqrtf(wave_sum(ss) * (1.f / DM) + EPS);
                u32x2* ho = (u32x2*)(hout + (size_t)row * DM) + lane_;
#pragma unroll
                for (int j = 0; j < 8; ++j) { const f32x4 a = *((const f32x4*)mA + lane_ + 64 * j), s = *((const f32x4*)mS + lane_ + 64 * j);
                    u32x2 o; o.x = pk2(v[j][0] * rstd * a[0] + s[0], v[j][1] * rstd * a[1] + s[1]); o.y = pk2(v[j][2] * rstd * a[2] + s[2], v[j][3] * rstd * a[3] + s[3]);
                    ho[64 * j] = o; }
            }
        }
    }
}

__device__ __forceinline__ int crow(int r, int h) { return (r & 3) + 8 * (r >> 2) + 4 * h; }
__device__ __forceinline__ unsigned off_b(unsigned row, unsigned ch) { return 256u * row + 16u * (ch ^ (((row & 3u) << 2) | ((row >> 2) & 3u))); }
typedef short s16x4 __attribute__((ext_vector_type(4)));
__device__ __forceinline__ s16x4 vtr(const LAS unsigned char* p) { return __builtin_bit_cast(s16x4, __builtin_amdgcn_ds_read_tr16_b64_v4i16((LAS s16x4*)p)); }
__device__ __forceinline__ bf16x8 pack8(float a0, float a1, float a2, float a3, float a4, float a5, float a6, float a7) {
    u32x4 p; p.x = pk2(a0, a1); p.y = pk2(a2, a3); p.z = pk2(a4, a5); p.w = pk2(a6, a7); return __builtin_bit_cast(bf16x8, p); }
__device__ __forceinline__ float gelu_fast(float v) {
    const float av = __builtin_fabsf(v), t = __builtin_amdgcn_rcpf(av * 0.2316418882f + 1.0f);
    float q = t * 0.5307027145f + (-0.7265760135f); q = q * t + 0.7107068705f; q = q * t + (-0.142248368f); q = q * t + 0.127414796f; q = q * t;
    const float e = __builtin_amdgcn_exp2f((v * v) * (-0.72134752044f));
    const float m = v * (q * e);
    return v < 0.f ? m : v - m;
}
__device__ __forceinline__ void phase_gmlp(Frame& F, const ArgV A, int l) {
    int vcu_ = F.vcu, gw_ = F.gw; asm volatile("" : "+s"(vcu_), "+s"(gw_)); (void)vcu_; (void)gw_;
    const int tid_ = fresh_tid(), lane = tid_ & 63, r32 = lane & 31, hh = lane >> 5;
    const bf16_t* proj = (const bf16_t*)(A.ws() + WS_PROJ); bf16_t* ymix = (bf16_t*)(A.ws() + WS_YMIX);
    const float *gm_norm_g = A.in(7) + l * 512, *gm_bs = A.in(9) + l * 512, *out_norm_g = A.in(12) + l * DMIX;
    const bf16_t* Wgm = (const bf16_t*)(A.ws() + WS_WGM) + (size_t)l * 4 * 128 * 128;
    LAS unsigned char* vimg = F.lds;
    LAS float* red = (LAS float*)(F.lds + 32768);
    const unsigned blk16 = (lane >> 4) & 1, tq = (lane & 15) >> 2, tp = lane & 3;
    const int tb = F.wave >> 1, kh = F.wave & 1;
    for (int u = vcu_; u < NT / 128 * 4; u += F.G) {
        const int g = u & 3, ch = u >> 2, row0 = ch * 128;
        {
            const int p = tid_ >> 2, seg = tid_ & 3;
            const u32x4* vp = (const u32x4*)(proj + (size_t)(row0 + p) * DIN + 512 + g * 128 + seg * 32);
            float x[32]; float ss = 0.f;
#pragma unroll
            for (int c = 0; c < 4; ++c) { const u32x4 w = vp[c];
                x[c * 8 + 0] = bflo(w.x); x[c * 8 + 1] = bfhi(w.x); x[c * 8 + 2] = bflo(w.y); x[c * 8 + 3] = bfhi(w.y);
                x[c * 8 + 4] = bflo(w.z); x[c * 8 + 5] = bfhi(w.z); x[c * 8 + 6] = bflo(w.w); x[c * 8 + 7] = bfhi(w.w); }
#pragma unroll
            for (int j = 0; j < 32; ++j) { x[j] = gelu_fast(x[j]); ss += x[j] * x[j]; }
            ss += __shfl_xor(ss, 1); ss += __shfl_xor(ss, 2);
            const float rv = 1.f / sqrtf(ss * (1.f / 128.f) + EPS);
            const float* gn = gm_norm_g + g * 128 + seg * 32;
#pragma unroll
            for (int c = 0; c < 4; ++c) { const f32x4 ga = *(const f32x4*)(gn + 8 * c), gb = *(const f32x4*)(gn + 8 * c + 4);
                *(LAS bf16x8*)(vimg + off_b((unsigned)p, (unsigned)(4 * seg + c))) = pack8(x[8 * c] * rv * ga[0], x[8 * c + 1] * rv * ga[1], x[8 * c + 2] * rv * ga[2], x[8 * c + 3] * rv * ga[3],
                                                                                         x[8 * c + 4] * rv * gb[0], x[8 * c + 5] * rv * gb[1], x[8 * c + 6] * rv * gb[2], x[8 * c + 7] * rv * gb[3]); }
        }
        __syncthreads();
        f32x16 acc[2];
#pragma unroll
        for (int kb = 0; kb < 2; ++kb)
#pragma unroll
            for (int q = 0; q < 16; ++q) acc[kb][q] = 0.f;
        const int t = 32 * tb + r32;
        const bf16x8* wrow = (const bf16x8*)(Wgm + ((size_t)g * 128 + t) * 128 + 8 * hh);
#pragma unroll 1
        for (int pb = 0; pb <= tb; ++pb) {
#pragma unroll
            for (int s2 = 0; s2 < 2; ++s2) {
                const bf16x8 bf = wrow[4 * pb + 2 * s2];
#pragma unroll
                for (int kb = 0; kb < 2; ++kb) {
                    const unsigned ra = (unsigned)(32 * pb + 16 * s2 + 8 * hh) + tq, rb = ra + 4u, cc = (unsigned)(2 * kh + kb);
                    const s16x4 lo4 = vtr(vimg + off_b(ra, 4u * cc + 2u * blk16 + (tp >> 1)) + 8u * (tp & 1));
                    const s16x4 hi4 = vtr(vimg + off_b(rb, 4u * cc + 2u * blk16 + (tp >> 1)) + 8u * (tp & 1));
                    const bf16x8 af = __builtin_shufflevector(lo4, hi4, 0, 1, 2, 3, 4, 5, 6, 7);
                    acc[kb] = __builtin_amdgcn_mfma_f32_32x32x16_bf16(af, bf, acc[kb], 0, 0, 0);
                }
            }
        }
        const float bias = gm_bs[g * 128 + t];
        float ss = 0.f;
#pragma unroll
        for (int kb = 0; kb < 2; ++kb)
#pragma unroll
            for (int g4 = 0; g4 < 4; ++g4) { const int k0 = 64 * kh + 32 * kb + 8 * g4 + 4 * hh;
                const u32x2 w = *(const u32x2*)(proj + (size_t)(row0 + t) * DIN + g * 128 + k0);
                const float u0 = gelu_fast(bflo(w.x)), u1 = gelu_fast(bfhi(w.x)), u2 = gelu_fast(bflo(w.y)), u3 = gelu_fast(bfhi(w.y));
                float y0 = u0 * (acc[kb][4 * g4] + bias), y1 = u1 * (acc[kb][4 * g4 + 1] + bias), y2 = u2 * (acc[kb][4 * g4 + 2] + bias), y3 = u3 * (acc[kb][4 * g4 + 3] + bias);
                acc[kb][4 * g4] = y0; acc[kb][4 * g4 + 1] = y1; acc[kb][4 * g4 + 2] = y2; acc[kb][4 * g4 + 3] = y3;
                ss += (y0 * y0 + y1 * y1) + (y2 * y2 + y3 * y3); }
        ss += __shfl_xor(ss, 32);
        if (hh == 0) red[F.wave * 32 + r32] = ss;
        __syncthreads();
        const float tot = red[(2 * tb) * 32 + r32] + red[(2 * tb + 1) * 32 + r32];
        const float ry = 1.f / sqrtf(tot * (1.f / 128.f) + EPS);
#pragma unroll
        for (int kb = 0; kb < 2; ++kb)
#pragma unroll
            for (int g4 = 0; g4 < 4; ++g4) { const int k0 = 64 * kh + 32 * kb + 8 * g4 + 4 * hh; const f32x4 og = *(const f32x4*)(out_norm_g + g * 128 + k0);
                u32x2 w; w.x = pk2(acc[kb][4 * g4] * ry * og[0], acc[kb][4 * g4 + 1] * ry * og[1]); w.y = pk2(acc[kb][4 * g4 + 2] * ry * og[2], acc[kb][4 * g4 + 3] * ry * og[3]);
                *(u32x2*)(ymix + (size_t)(row0 + t) * DMIX + g * 128 + k0) = w; }
        __syncthreads();
    }
}

__device__ __forceinline__ void phase_attn(Frame& F, const ArgV A, int l) {
    int vcu_ = F.vcu, gw_ = F.gw; asm volatile("" : "+s"(vcu_), "+s"(gw_)); (void)vcu_; (void)gw_;
    const int tid_ = fresh_tid(), lane = tid_ & 63, r32 = lane & 31, hh = lane >> 5;
    const bf16_t* proj = (const bf16_t*)(A.ws() + WS_PROJ); bf16_t* ymix = (bf16_t*)(A.ws() + WS_YMIX); const float* ksq = (const float*)(A.ws() + WS_KSQ);
    const float *qg = A.in(10) + l * 128, *kg = A.in(11) + l * 128, *out_norm_g = A.in(12) + l * DMIX;
    LAS unsigned char* vimg0 = F.lds + F.wave * 16512;
    LAS float* rkbuf = (LAS float*)(vimg0 + 16384);
    const float c2 = 1.4426950408889634f * 0.08838834764831845f;
    LAS float* gqk = (LAS float*)(F.lds + 8 * 16512);
    __syncthreads();
    if (tid_ < 128) gqk[tid_] = qg[tid_] * kg[tid_] * c2;
    __syncthreads();
    bf16x8 tf[2];
#pragma unroll
    for (int s = 0; s < 2; ++s)
#pragma unroll
        for (int j = 0; j < 8; ++j) tf[s][j] = ((16 * s + 8 * (j >> 2) + 4 * hh + (j & 3)) >= r32) ? (short)0x3F80 : (short)0;
    const unsigned blk16 = (lane >> 4) & 1, tq = (lane & 15) >> 2, tp = lane & 3;
    for (int u = gw_; u < NB * 4 * (SEQ / 32); u += F.NGW) {
        const int qb = u % (SEQ / 32), hd = (u / (SEQ / 32)) & 3, b = u / (4 * (SEQ / 32));
        const size_t rowq = (size_t)b * SEQ + qb * 32 + r32;
        bf16x8 qf[8];
        {
            const f32x4 qs4 = *(const f32x4*)(ksq + (rowq * 8 + hd) * 4);
            const float rq = 1.f / sqrtf(((qs4[0] + qs4[1]) + (qs4[2] + qs4[3])) * (1.f / 128.f) + EPS);
            const u32x4* qp = (const u32x4*)(proj + rowq * DIN + 1024 + hd * 128 + 8 * hh);
#pragma unroll
            for (int s = 0; s < 8; ++s) { const u32x4 w = qp[2 * s]; const int d0 = 16 * s + 8 * hh;
                const f32x4 ga = *(const LAS f32x4*)(gqk + d0), gb = *(const LAS f32x4*)(gqk + d0 + 4);
                qf[s] = pack8(bflo(w.x) * rq * ga[0], bfhi(w.x) * rq * ga[1], bflo(w.y) * rq * ga[2], bfhi(w.y) * rq * ga[3],
                              bflo(w.z) * rq * gb[0], bfhi(w.z) * rq * gb[1], bflo(w.w) * rq * gb[2], bfhi(w.w) * rq * gb[3]); }
        }
        f32x16 o[4];
#pragma unroll
        for (int db = 0; db < 4; ++db)
#pragma unroll
            for (int q = 0; q < 16; ++q) o[db][q] = 0.f;
        float R = 0.f;
        bf16x8 kf[8]; float rkv = 0.f; unsigned vbuf = 0u;
#define ATT_LOAD_TILE(kt_, buf_) do { const size_t rk0_ = (size_t)b * SEQ + (size_t)(kt_) * 32; \
            const bf16x8* kp_ = (const bf16x8*)(proj + (rk0_ + r32) * DIN + 1536 + hd * 128 + 8 * hh); \
            _Pragma("unroll") for (int s_ = 0; s_ < 8; ++s_) kf[s_] = kp_[2 * s_]; \
            _Pragma("unroll") for (int i_ = 0; i_ < 8; ++i_) { const unsigned row_ = 4u * i_ + (lane >> 4), ch_ = (lane & 15u) ^ (((row_ & 3u) << 2) | ((row_ >> 2) & 3u)); \
                __builtin_amdgcn_global_load_lds((const unsigned*)(proj + (rk0_ + row_) * DIN + 2048 + hd * 128 + 8 * ch_), (LAS unsigned*)(vimg0 + (buf_) * 8192u + i_ * 1024u), 16, 0, 0); } \
            { const f32x4 k4_ = *(const f32x4*)(ksq + ((rk0_ + r32) * 8 + 4 + hd) * 4); rkv = 1.f / sqrtf(((k4_[0] + k4_[1]) + (k4_[2] + k4_[3])) * (1.f / 128.f) + EPS); } } while (0)
        ATT_LOAD_TILE(qb, 0u);
#pragma unroll 1
        for (int kt = qb; kt >= 0; --kt) {
            const LAS unsigned char* vimg = vimg0 + vbuf * 8192u;
            asm volatile("s_waitcnt vmcnt(0)" ::: "memory");
            if (lane < 32) rkbuf[lane] = rkv;
            f32x16 z;
#pragma unroll
            for (int q = 0; q < 16; ++q) z[q] = 0.f;
#pragma unroll
            for (int s = 0; s < 8; ++s) z = __builtin_amdgcn_mfma_f32_32x32x16_bf16(kf[s], qf[s], z, 0, 0, 0);
            __builtin_amdgcn_sched_barrier(0);
            if (kt > 0) { ATT_LOAD_TILE(kt - 1, vbuf ^ 1u); }
            __builtin_amdgcn_sched_barrier(0);
            f32x16 Lh;
            const bool diag = (kt == qb);
#pragma unroll
            for (int g = 0; g < 4; ++g) { const f32x4 rk4 = *(const LAS f32x4*)(rkbuf + 8 * g + 4 * hh);
#pragma unroll
                for (int e = 0; e < 4; ++e) { const int q = 4 * g + e; const float z2 = z[q] * rk4[e]; z[q] = z2 + R;
                    const bool valid = !diag || (crow(q, hh) < r32);
                    Lh[q] = valid ? -__builtin_amdgcn_logf(1.f + __builtin_amdgcn_exp2f(z2)) : 0.f; } }
            const float seed0 = z[0];
#pragma unroll
            for (int s = 0; s < 2; ++s) {
                const bf16x8 lhi = pack8(Lh[8 * s], Lh[8 * s + 1], Lh[8 * s + 2], Lh[8 * s + 3], Lh[8 * s + 4], Lh[8 * s + 5], Lh[8 * s + 6], Lh[8 * s + 7]);
                float lo[8];
#pragma unroll
                for (int j = 0; j < 8; ++j) lo[j] = Lh[8 * s + j] - __builtin_bit_cast(float, ((unsigned)(unsigned short)lhi[j]) << 16);
                const bf16x8 llo = pack8(lo[0], lo[1], lo[2], lo[3], lo[4], lo[5], lo[6], lo[7]);
                z = __builtin_amdgcn_mfma_f32_32x32x16_bf16(tf[s], lhi, z, 0, 0, 0);
                z = __builtin_amdgcn_mfma_f32_32x32x16_bf16(tf[s], llo, z, 0, 0, 0);
            }
            const float tot = z[0] - seed0;
#pragma unroll
            for (int q = 0; q < 16; ++q) { const bool valid = !diag || (crow(q, hh) < r32); const float a = __builtin_amdgcn_exp2f(z[q]); z[q] = valid ? a : 0.f; }
            R += __shfl(tot, r32);
#pragma unroll
            for (int s = 0; s < 2; ++s) {
                const bf16x8 pf = pack8(z[8 * s], z[8 * s + 1], z[8 * s + 2], z[8 * s + 3], z[8 * s + 4], z[8 * s + 5], z[8 * s + 6], z[8 * s + 7]);
#pragma unroll
                for (int db = 0; db < 4; ++db) {
                    const unsigned ra = (unsigned)(16 * s + 4 * hh) + tq, rb = ra + 8u;
                    const s16x4 lo4 = vtr(vimg + off_b(ra, 4u * db + 2u * blk16 + (tp >> 1)) + 8u * (tp & 1));
                    const s16x4 hi4 = vtr(vimg + off_b(rb, 4u * db + 2u * blk16 + (tp >> 1)) + 8u * (tp & 1));
                    const bf16x8 vf = __builtin_shufflevector(lo4, hi4, 0, 1, 2, 3, 4, 5, 6, 7);
                    o[db] = __builtin_amdgcn_mfma_f32_32x32x16_bf16(vf, pf, o[db], 0, 0, 0);
                }
            }
            vbuf ^= 1u;
            if (__builtin_amdgcn_ballot_w64(R >= -150.f) == 0ull) break;
        }
#undef ATT_LOAD_TILE
        asm volatile("s_waitcnt vmcnt(0)" ::: "memory");
        float ss = 0.f;
#pragma unroll
        for (int db = 0; db < 4; ++db)
#pragma unroll
            for (int q = 0; q < 16; ++q) ss += o[db][q] * o[db][q];
        ss += __shfl_xor(ss, 32);
        const float rs = 1.f / sqrtf(ss * (1.f / 128.f) + EPS);
        bf16_t* yo = ymix + rowq * DMIX + 512 + hd * 128;
        const float* og = out_norm_g + 512 + hd * 128;
#pragma unroll
        for (int db = 0; db < 4; ++db)
#pragma unroll
            for (int g = 0; g < 4; ++g) { const int d0 = 32 * db + 8 * g + 4 * hh; const f32x4 gg = *(const f32x4*)(og + d0);
                u32x2 w; w.x = pk2(o[db][4 * g] * rs * gg[0], o[db][4 * g + 1] * rs * gg[1]); w.y = pk2(o[db][4 * g + 2] * rs * gg[2], o[db][4 * g + 3] * rs * gg[3]);
                *(u32x2*)(yo + d0) = w; }
    }
}

__device__ __forceinline__ void phase_router(Frame& F, const ArgV A, int l) {
    int vcu_ = F.vcu, gw_ = F.gw; asm volatile("" : "+s"(vcu_), "+s"(gw_)); (void)vcu_; (void)gw_;
    const int tid_ = fresh_tid(), lane = tid_ & 63;
    const float* modv = (const float*)(A.ws() + WS_MODV); bf16_t* hout = (bf16_t*)A.out(); const bf16_t* xb = (const bf16_t*)(A.ws() + WS_XB);
    int* tok = (int*)(A.ws() + WS_TOK); int* list = (int*)(A.ws() + WS_LIST);
    const bf16_t* WrT = (const bf16_t*)(A.ws() + WS_WRT) + (size_t)l * 64 * DM;
    const float *b_group = A.in(16) + l * 4, *b_route = A.in(18) + l * 32;
    volatile LAS unsigned* lcnt = F.MISC + 128;
    for (int blk = vcu_; blk < NT / 128; blk += F.G) {
        const int b = (blk * 128) / SEQ;
        const float* mA_ = modv + ((size_t)(l * NB + b) * 6 + 4) * DM; const float* mS_ = modv + ((size_t)(l * NB + b) * 6 + 3) * DM;
        if (tid_ < 64) lcnt[tid_] = 0u;
#pragma unroll 1
        for (int i = 0; i < 16; ++i) {
            const int row = blk * 128 + F.wave * 16 + i;
            const float *mA = mA_, *mS = mS_;
            asm volatile("" : "+s"(mA), "+s"(mS));
            const u32x2* xr = (const u32x2*)(xb + (size_t)row * DM) + lane;
            f32x4 v[8]; float ss = 0.f;
#pragma unroll
            for (int j = 0; j < 8; ++j) { const u32x2 w = xr[64 * j]; v[j] = (f32x4){bflo(w.x), bfhi(w.x), bflo(w.y), bfhi(w.y)}; ss += (v[j][0] * v[j][0] + v[j][1] * v[j][1]) + (v[j][2] * v[j][2] + v[j][3] * v[j][3]); }
            const float rstd = 1.f / sqrtf(wave_sum(ss) * (1.f / DM) + EPS);
            u32x2* ho = (u32x2*)(hout + (size_t)row * DM) + lane;
#pragma unroll
            for (int j = 0; j < 8; ++j) { const f32x4 a = *((const f32x4*)mA + lane + 64 * j), s = *((const f32x4*)mS + lane + 64 * j);
                u32x2 o; o.x = pk2(v[j][0] * rstd * a[0] + s[0], v[j][1] * rstd * a[1] + s[1]); o.y = pk2(v[j][2] * rstd * a[2] + s[2], v[j][3] * rstd * a[3] + s[3]); ho[64 * j] = o; }
        }
        asm volatile("s_waitcnt vmcnt(0)" ::: "memory");
        __syncthreads();
        int e0 = 0, e1 = 0, lp0 = 0, lp1 = 0; float w0 = 0.f, w1 = 0.f; bool owner = false;
        const int r32 = lane & 31, hh = lane >> 5;
        const int myrow = blk * 128 + F.wave * 32 + r32;
        if (F.wave < 4) {
            f32x16 acc0, acc1;
#pragma unroll
            for (int q = 0; q < 16; ++q) { acc0[q] = 0.f; acc1[q] = 0.f; }
            const bf16x8* hb = (const bf16x8*)(hout + (size_t)myrow * DM + 8 * hh);
            const bf16x8* wa = (const bf16x8*)(WrT + (size_t)r32 * DM + 8 * hh);
            const bf16x8* wb = (const bf16x8*)(WrT + (size_t)(32 + r32) * DM + 8 * hh);
#pragma unroll 8
            for (int s = 0; s < 128; ++s) { const bf16x8 bv = hb[2 * s], a0 = wa[2 * s], a1 = wb[2 * s];
                acc0 = __builtin_amdgcn_mfma_f32_32x32x16_bf16(a0, bv, acc0, 0, 0, 0);
                acc1 = __builtin_amdgcn_mfma_f32_32x32x16_bf16(a1, bv, acc1, 0, 0, 0); }
            float gl[4];
#pragma unroll
            for (int q = 0; q < 4; ++q) gl[q] = acc1[q] + b_group[q];
            int gi = 0; float gm = gl[0];
#pragma unroll
            for (int q = 1; q < 4; ++q) if (gl[q] > gm) { gm = gl[q]; gi = q; }
            float den = 0.f;
#pragma unroll
            for (int q = 0; q < 4; ++q) den += __expf(gl[q] - gm);
            const float pg = 1.f / den;
            owner = ((gi >> 1) == hh);
            float ev[8];
#pragma unroll
            for (int q = 0; q < 8; ++q) ev[q] = ((gi & 1) ? acc0[8 + q] : acc0[q]) + b_route[(owner ? gi : 2 * hh) * 8 + q];
            int i0 = 0; float v0 = ev[0];
#pragma unroll
            for (int q = 1; q < 8; ++q) if (ev[q] > v0) { v0 = ev[q]; i0 = q; }
            int i1 = -1; float v1 = -3.0e38f;
#pragma unroll
            for (int q = 0; q < 8; ++q) if (q != i0 && ev[q] > v1) { v1 = ev[q]; i1 = q; }
            const float e1x = __expf(v1 - v0); w0 = pg / (1.f + e1x); w1 = pg * e1x / (1.f + e1x);
            e0 = gi * 8 + i0; e1 = gi * 8 + i1;
            if (owner) { lp0 = (int)__hip_atomic_fetch_add((LAS unsigned*)(lcnt + e0), 1u, __ATOMIC_RELAXED, __HIP_MEMORY_SCOPE_WORKGROUP);
                         lp1 = (int)__hip_atomic_fetch_add((LAS unsigned*)(lcnt + e1), 1u, __ATOMIC_RELAXED, __HIP_MEMORY_SCOPE_WORKGROUP); }
        }
        __syncthreads();
        if (tid_ < 32) { const unsigned n = lcnt[tid_]; unsigned base = 0u; if (n) base = atomicAdd(F.ctl + CW_CNT + (l * 32 + tid_) * 64, n); lcnt[32 + tid_] = base; }
        __syncthreads();
        if (owner) {
            const int p0 = (int)lcnt[32 + e0] + lp0, p1 = (int)lcnt[32 + e1] + lp1;
            list[(size_t)e0 * NT + p0] = myrow; list[(size_t)e1 * NT + p1] = myrow;
            tok[myrow * 8 + 0] = e0; tok[myrow * 8 + 1] = e1; tok[myrow * 8 + 2] = p0; tok[myrow * 8 + 3] = p1;
            tok[myrow * 8 + 4] = __builtin_bit_cast(int, w0); tok[myrow * 8 + 5] = __builtin_bit_cast(int, w1);
        }
        __syncthreads();
    }
}

__global__ void __launch_bounds__(512, 2) fwd_kernel(Args args_unused) {
    extern __shared__ __attribute__((aligned(16))) unsigned char lds_raw[];
    Frame F;
    F.lds = (LAS unsigned char*)lds_raw;
    F.MISC = (volatile LAS unsigned*)(F.lds + MISC_OFF);
    F.tid = threadIdx.x; F.lane = F.tid & 63; F.wave = __builtin_amdgcn_readfirstlane(F.tid >> 6);
    F.G = gridDim.x; { const int bx = blockIdx.x; F.vcu = (F.G % 8 == 0) ? (bx % 8) * (F.G / 8) + bx / 8 : bx; }
    F.gw = F.vcu * 8 + F.wave; F.NGW = F.G * 8;
    { const ArgV a0 = get_args(); F.ctl = (unsigned*)(a0.ws() + WS_CTL); }
    for (int u = F.tid; u < 256; u += 512) F.MISC[u] = 0u;
    __syncthreads();
    int lo, hi; { const ArgV a0 = get_args(); lo = a0.ph_lo(); hi = a0.ph_hi(); }
    XcdBarrier bar; bar.bar = F.ctl + CW_BAR; bar.x = 0; bar.st = nullptr;
    if (hi - lo > 1) bar = xcd_barrier_post(F.ctl + CW_BAR, F.MISC);
#ifndef PH_MASK
#define PH_MASK 0x1ff
#endif
#define PM(j) (((PH_MASK) >> (j)) & 1)
#define IN(k) (lo <= (k) && (k) < hi)
#define SEAM(k) do { if (IN(k) && IN((k) + 1)) xcd_barrier(bar); } while (0)
#define PB(kind) do { if ((kind) == PROBE_KIND && blockIdx.x == 0 && threadIdx.x == 0) { const unsigned long long t_ = __builtin_amdgcn_s_memrealtime(); F.MISC[200] = (unsigned)t_; F.MISC[201] = (unsigned)(t_ >> 32); } } while (0)
#define PE(kind) do { if ((kind) == PROBE_KIND && blockIdx.x == 0 && threadIdx.x == 0) { const unsigned long long t_ = __builtin_amdgcn_s_memrealtime() - (((unsigned long long)F.MISC[201] << 32) | F.MISC[200]); \
        const unsigned long long a_ = (((unsigned long long)F.MISC[203] << 32) | F.MISC[202]) + t_; F.MISC[202] = (unsigned)a_; F.MISC[203] = (unsigned)(a_ >> 32); } } while (0)
    PB(0); if (PM(0) && IN(0)) { const ArgV args = get_args(); phase_modpart(F, args.in(1), args.in(2), (float*)(args.ws() + WS_MODPART)); } SEAM(0); PE(0);
    PB(1); if (PM(0) && IN(1)) { const ArgV args = get_args(); phase_prep(F, args); } SEAM(1); PE(1);
    for (int l = 0; l < NL; ++l) {
        const int pb = 2 + 7 * l;
        PB(2); if (PM(1) && IN(pb + 0)) { const ArgV args = get_args(); if (l == 0) phase_norm1<0>(F, args, l); else phase_norm1<1>(F, args, l); } SEAM(pb + 0); PE(2);
        PB(3); if (PM(2) && IN(pb + 1)) {
            const ArgV args = get_args();
            DenseSched S; S.init(NT, DIN, DM, (const bf16_t*)(args.ws() + WS_WINT) + (size_t)l * DIN * DM, F.G, (int)blockIdx.x);
            EpiProj E{(bf16_t*)(args.ws() + WS_PROJ), (float*)(args.ws() + WS_KSQ)};
            pg8::gemm_phase<EpiProj, DenseSched>(F.lds, (const bf16_t*)args.out(), DM, S, E);
        } SEAM(pb + 1); PE(3);
        PB(4); if (IN(pb + 2)) { PB(10); if (PM(3)) { const ArgV args = get_args(); phase_gmlp(F, args, l); } PE(10); PB(11); if (PM(4)) { const ArgV args = get_args(); phase_attn(F, args, l); } PE(11); } SEAM(pb + 2); PE(4);
        PB(5); if (PM(7) && IN(pb + 3)) {
            const ArgV args = get_args();
            DenseSched S; S.init(NT, DM, DMIX, (const bf16_t*)(args.ws() + WS_WOUTT) + (size_t)l * DM * DMIX, F.G, (int)blockIdx.x);
            EpiOut E{(bf16_t*)(args.ws() + WS_XB), (const float*)(args.ws() + WS_MODV) + ((size_t)(l * NB) * 6 + 2) * DM};
            pg8::gemm_phase<EpiOut, DenseSched>(F.lds, (const bf16_t*)(args.ws() + WS_YMIX), DMIX, S, E);
        } SEAM(pb + 3); PE(5);
        PB(6); if (PM(5) && IN(pb + 4)) { const ArgV args = get_args(); phase_router(F, args, l); } SEAM(pb + 4); PE(6);
        PB(7); if (PM(6) && IN(pb + 5)) {
            const ArgV args = get_args();
            build_tiles(F, l);
            MoeSched<true> S; S.tp = F.MISC + 16; S.cnt = F.MISC + 64; S.te = (const volatile LAS unsigned*)(F.lds + TILE_E_OFF); S.list = (const int*)(args.ws() + WS_LIST);
            S.Bt = (const bf16_t*)(args.ws() + WS_WGUT) + (size_t)l * NE * 512 * DM; S.bstride_e = (size_t)512 * DM; S.K = DM; S.npn = 2; S.lognpn = 1; S.G = F.G; S.c = F.vcu;
            EpiAct E{(bf16_t*)(args.ws() + WS_ACT)};
            pg8::gemm_phase<EpiAct, MoeSched<true> >(F.lds, (const bf16_t*)args.out(), DM, S, E);
        } SEAM(pb + 5); PE(7);
        PB(8); if (PM(8) && IN(pb + 6)) {
            const ArgV args = get_args();
            build_tiles(F, l);
            MoeSched<false> S; S.tp = F.MISC + 16; S.cnt = F.MISC + 64; S.te = (const volatile LAS unsigned*)(F.lds + TILE_E_OFF); S.list = nullptr;
            S.Bt = (const bf16_t*)(args.ws() + WS_WDT) + (size_t)l * NE * DM * DE; S.bstride_e = (size_t)DM * DE; S.K = DE; S.npn = 8; S.lognpn = 3; S.G = F.G; S.c = F.vcu;
            EpiY E{(bf16_t*)(args.ws() + WS_YSLOT)};
            pg8::gemm_phase<EpiY, MoeSched<false> >(F.lds, (const bf16_t*)(args.ws() + WS_ACT), DE, S, E);
        } SEAM(pb + 6); PE(8);
    }
    if (PM(1) && IN(30)) { const ArgV args = get_args(); phase_norm1<2>(F, args, NL); }
    if (PROBE_KIND >= 0 && blockIdx.x == 0 && threadIdx.x == 0) { const unsigned long long pacc = (((unsigned long long)F.MISC[203] << 32) | F.MISC[202]);
        const unsigned long long t0 = __builtin_amdgcn_s_memrealtime(); while (__builtin_amdgcn_s_memrealtime() - t0 < 4ull * pacc) __builtin_amdgcn_s_sleep(20); }
#undef IN
#undef SEAM
}

extern "C" void kernel_launch(void* const* d_in, const int* in_sizes, int n_in, void* d_out, int out_size, void* d_ws, size_t ws_size, hipStream_t stream) {
    static int grid = 0;
    if (grid == 0) {
        if (n_in != 22 || out_size != NT * DM || ws_size < WS_END) { fprintf(stderr, "kernel_launch: unexpected problem (n_in %d out %d ws %zu)\n", n_in, out_size, ws_size); grid = -1; return; }
        int dev = 0, cus = 0;
        if (hipGetDevice(&dev) != hipSuccess || hipDeviceGetAttribute(&cus, hipDeviceAttributeMultiprocessorCount, dev) != hipSuccess) { grid = -1; return; }
        if (hipFuncSetAttribute((const void*)fwd_kernel, hipFuncAttributeMaxDynamicSharedMemorySize, LDS_BYTES) != hipSuccess) { fprintf(stderr, "kernel_launch: hipFuncSetAttribute failed\n"); grid = -1; return; }
        int per_cu = 0;
        (void)hipOccupancyMaxActiveBlocksPerMultiprocessor(&per_cu, (const void*)fwd_kernel, 512, LDS_BYTES);
        (void)hipGetLastError();
        grid = cus;
    }
    if (grid < 0) return;
    (void)hipMemsetAsync((char*)d_ws + WS_CTL, 0, CTL_ZERO_BYTES, stream);
    Args a{};
    for (int i = 0; i < 22; ++i) a.in[i] = (const float*)d_in[i];
    a.out = (float*)d_out; a.ws = (unsigned char*)d_ws;
#if MK_ONE_LAUNCH
    a.ph_lo = 0; a.ph_hi = NPHASE;
    hipLaunchKernelGGL(fwd_kernel, dim3(grid), dim3(512), LDS_BYTES, stream, a);
#else
    for (int p = 0; p < NPHASE; ++p) { a.ph_lo = p; a.ph_hi = p + 1; hipLaunchKernelGGL(fwd_kernel, dim3(grid), dim3(512), LDS_BYTES, stream, a); }
#endif
}
```

```cpp
#include <hip/hip_runtime.h>
#include <cstdio>
#include <cstdint>

#ifndef PROBE_KIND
#define PROBE_KIND -1
#endif
#ifndef MK_ONE_LAUNCH
#define MK_ONE_LAUNCH 1
#endif

#define LAS __attribute__((address_space(3)))
#define GAS __attribute__((address_space(1)))
typedef unsigned short bf16_t;
typedef short bf16x8 __attribute__((ext_vector_type(8)));
typedef float f32x4 __attribute__((ext_vector_type(4)));
typedef float f32x2 __attribute__((ext_vector_type(2)));
typedef float f32x16 __attribute__((ext_vector_type(16)));
typedef unsigned u32x4 __attribute__((ext_vector_type(4)));
typedef unsigned u32x2 __attribute__((ext_vector_type(2)));
typedef __bf16 bf16x2_t __attribute__((ext_vector_type(2)));

constexpr int DM = 2048, NB = 4, SEQ = 8192, NL = 4, NT = NB * SEQ;
constexpr int DIN = 2560, DMIX = 1024, NE = 32, DE = 256, NMOD = 6 * DM;
constexpr int SLOT_TILES = NT * 2 / 256 + NE, NSLOT = SLOT_TILES * 256;
constexpr float EPS = 1e-6f;
constexpr int NPHASE = 31;

constexpr size_t MiB = 1u << 20;
constexpr size_t WS_CTL = 0, CTL_ZERO_BYTES = 1 * MiB;
constexpr size_t WS_MODPART = 1 * MiB;
constexpr size_t WS_MODV = 2 * MiB;
constexpr size_t WS_TOK = 3 * MiB;
constexpr size_t WS_LIST = 4 * MiB;
constexpr size_t WS_KSQ = 8 * MiB;
constexpr size_t WS_WINT = 12 * MiB;
constexpr size_t WS_WOUTT = 52 * MiB;
constexpr size_t WS_WGUT = 68 * MiB;
constexpr size_t WS_WDT = 324 * MiB;
constexpr size_t WS_XB = 452 * MiB;
constexpr size_t WS_PROJ = 580 * MiB;
constexpr size_t WS_YMIX = 740 * MiB;
constexpr size_t WS_ACT = 804 * MiB;
constexpr size_t WS_YSLOT = 840 * MiB;
constexpr size_t WS_WRT = 1128 * MiB;
constexpr size_t WS_WGM = 1129 * MiB;
constexpr size_t WS_END = 1130 * MiB;
static_assert(WS_ACT + (size_t)NSLOT * 256 * 2 <= WS_YSLOT && WS_YSLOT + (size_t)NSLOT * 2048 * 2 <= WS_WRT, "ws map");
constexpr int CW_BAR = 4096;
constexpr int CW_CNT = 16384;

constexpr int LDS_BYTES = 147456;
constexpr int TILE_E_OFF = 131072;
constexpr int OFFN_OFF = 133120;
constexpr int MISC_OFF = 147456 - 1024;

#define RLX_AGENT __ATOMIC_RELAXED, __HIP_MEMORY_SCOPE_AGENT
__device__ __forceinline__ unsigned f2bf(float f) { unsigned u = __builtin_bit_cast(unsigned, f); return (u + 0x7fffu + ((u >> 16) & 1u)) >> 16; }
__device__ __forceinline__ unsigned pk2(float lo, float hi) { f32x2 v = {lo, hi}; bf16x2_t b = __builtin_convertvector(v, bf16x2_t); return __builtin_bit_cast(unsigned, b); }
__device__ __forceinline__ float bflo(unsigned u) { return __builtin_bit_cast(float, u << 16); }
__device__ __forceinline__ float bfhi(unsigned u) { return __builtin_bit_cast(float, u & 0xffff0000u); }
__device__ __forceinline__ float wave_sum(float v) {
#pragma unroll
    for (int o = 1; o < 64; o <<= 1) v += __shfl_xor(v, o);
    return v;
}
__device__ __forceinline__ int fresh_tid() { int t = threadIdx.x; asm volatile("" : "+v"(t)); return t; }
__device__ __forceinline__ float gelu_exact(float x) { return 0.5f * x * (1.f + erff(x * 0.70710678118654752f)); }
__device__ __forceinline__ float silu_f(float x) { return x / (1.f + __expf(-x)); }

#define XB_TMO      128
#define XB_XCNT(j)  (256  + 64 * (j))
#define XB_XSUB(j)  (1280 + 64 * (j))
#define XB_XGEN(j)  (2304 + 64 * (j))
#define XB_TOP      3328
#define XB_TOPGEN   3392
#define XCD_BAR_WORDS 3456
#define XB_SPIN_CAP (1u << 22)
__device__ __forceinline__ unsigned xb_ld(unsigned* p)              { return __hip_atomic_load(p, __ATOMIC_RELAXED, __HIP_MEMORY_SCOPE_AGENT); }
__device__ __forceinline__ unsigned xb_add(unsigned* p, unsigned v) { return __hip_atomic_fetch_add(p, v, __ATOMIC_RELAXED, __HIP_MEMORY_SCOPE_AGENT); }
__device__ __forceinline__ unsigned xb_xcc_id() { return (unsigned)__builtin_amdgcn_s_getreg((3 << 11) | 20) & 0xFu; }
#define XB_SPIN(cond, bar) do { unsigned _sp = 0; while (cond) { __builtin_amdgcn_s_sleep(1); \
    if ((++_sp & 255u) == 0u) { if (xb_ld(&(bar)[XB_TMO])) break; if (_sp > XB_SPIN_CAP) { atomicAdd(&(bar)[XB_TMO], 1u); break; } } } } while (0)
struct XcdBarrier { unsigned* bar; unsigned x; volatile LAS unsigned* st; };
__device__ __forceinline__ XcdBarrier xcd_barrier_post(unsigned* bar, volatile LAS unsigned* st) {
    XcdBarrier b; b.bar = bar; b.x = xb_xcc_id(); b.st = st;
    if (threadIdx.x == 0) (void)xb_add(&bar[XB_XCNT(b.x)], 1u);
    return b;
}
__device__ __forceinline__ void xcd_barrier_complete(unsigned* bar, unsigned x, unsigned& nloc, unsigned& nx) {
    const unsigned G = gridDim.x * gridDim.y * gridDim.z;
    unsigned sum, cnt, mine, sp = 0u;
    for (;;) {
        sum = 0u; cnt = 0u; mine = 0u;
#pragma unroll
        for (unsigned j = 0; j < 16; ++j) { const unsigned c = xb_ld(&bar[XB_XCNT(j)]); sum += c; cnt += (c > 0u) ? 1u : 0u; mine = (j == x) ? c : mine; }
        if (sum == G) break;
        __builtin_amdgcn_s_sleep(1);
        if ((++sp & 255u) == 0u) { if (xb_ld(&bar[XB_TMO])) break; if (sp > XB_SPIN_CAP) { atomicAdd(&bar[XB_TMO], 1u); break; } }
    }
    nloc = mine > 0u ? mine : 1u; nx = cnt > 0u ? cnt : 1u;
}
__device__ __forceinline__ void xcd_barrier(const XcdBarrier& b) {
    asm volatile("s_waitcnt vmcnt(0)" ::: "memory");
    __syncthreads();
    if (threadIdx.x == 0) {
        unsigned* bar = b.bar; unsigned bx = b.x;
        asm volatile("" : "+s"(bar), "+s"(bx));
        __builtin_amdgcn_s_waitcnt(0);
        unsigned nloc = b.st[0], nx = b.st[1];
        if (nloc == 0u) { xcd_barrier_complete(bar, bx, nloc, nx); b.st[0] = nloc; b.st[1] = nx; }
        const unsigned old = xb_add(&bar[XB_XSUB(bx)], 1u);
        const unsigned gen = old / nloc;
        if (old + 1u == (gen + 1u) * nloc) {
            __builtin_amdgcn_fence(__ATOMIC_RELEASE, "agent");
            asm volatile("s_waitcnt vmcnt(0)" ::: "memory");
            const unsigned og = xb_add(&bar[XB_TOP], 1u);
            const unsigned tg = og / nx;
            if (og + 1u == (tg + 1u) * nx) xb_add(&bar[XB_TOPGEN], 1u);
            else XB_SPIN(xb_ld(&bar[XB_TOPGEN]) == tg, bar);
            __builtin_amdgcn_fence(__ATOMIC_ACQUIRE, "agent");
            xb_add(&bar[XB_XGEN(bx)], 1u);
            asm volatile("s_waitcnt vmcnt(0)" ::: "memory");
        } else {
            XB_SPIN(xb_ld(&bar[XB_XGEN(bx)]) == gen, bar);
            __builtin_amdgcn_fence(__ATOMIC_ACQUIRE, "agent");
            asm volatile("s_waitcnt vmcnt(0)" ::: "memory");
        }
    }
    __syncthreads();
}

namespace pg8 {
constexpr int BM = 256, BK = 64, HALF = 128, HTB = HALF * BK * 2, NXCD = 8, WGM = 8;
__device__ __forceinline__ int lds_byte(int r, int c) { const int st = (r >> 4) * 2 + (c >> 5), rr = r & 15, cc = c & 31, ob = rr * 64 + cc * 2; return st * 1024 + (ob ^ (((ob >> 9) & 1) << 5)); }
__device__ __forceinline__ void stage_rc(int b, int& R, int& C) { const int st = b / 1024, sb = b % 1024, swz = sb ^ (((sb >> 9) & 1) << 5); R = (st >> 1) * 16 + swz / 64; C = (st & 1) * 32 + (swz % 64) / 2; }
__device__ __forceinline__ int perm32(int rho) { const int n = rho >> 4, i = rho & 15; return 8 * (i >> 2) + 4 * n + (i & 3); }

template <class Epi, class Sched>
__device__ __forceinline__ void gemm_phase(LAS unsigned char* lds, const bf16_t* Abase, const int K, const Sched& S, const Epi& E) {
    typedef typename Sched::Unit Unit;
    constexpr bool GATHER = Sched::GATHER;
    const int tid = fresh_tid(), wid = __builtin_amdgcn_readfirstlane(tid >> 6), lane = tid & 63, wr = wid >> 2, wc = wid & 3, fr = lane & 15, fq = lane >> 4;
    const int nt = K / BK;
    unsigned voffA[2], voffB[2];
#pragma unroll
    for (int i = 0; i < 2; ++i) { int R, C; stage_rc(tid * 16 + i * 8192, R, C); const int Rb = Epi::PERM ? ((R & ~31) + perm32(R & 31)) : R;
        voffA[i] = (unsigned)(R * K + C) * 2u; voffB[i] = (unsigned)(Rb * K + C) * 2u; }
    const size_t kstep = (size_t)(BK * 2);
    const size_t hstep = (size_t)HALF * K * 2;
    const unsigned ldsw0 = (unsigned)wid * 1024u; unsigned ldsw = ldsw0;
    const int aoff = lds_byte(wr * 64 + fr, fq * 8), boff = lds_byte(wc * 32 + fr, fq * 8);
    const char* Ab = (const char*)Abase;
#define PG8_SA(b, h) (((b) * 2 + (h)) * HTB)
#define PG8_SB(b, h) ((4 + (b) * 2 + (h)) * HTB)
#define PG8_STAGE(bufoff, gbase, voff) do { _Pragma("unroll") for (int _i = 0; _i < 2; ++_i) \
        __builtin_amdgcn_global_load_lds((const unsigned*)((const char*)(gbase) + (voff)[_i]), (LAS unsigned*)(lds + (bufoff) + ldsw + _i * 8192), 16, 0, 0); } while (0)
#define PG8_STAGEA(bufoff, p, kb, off, h) do { if constexpr (GATHER) { PG8_STAGE(bufoff, Ab + (kb), (off) + 2 * (h)); } else { PG8_STAGE(bufoff, (p) + (h) * hstep, voffA); } } while (0)
#define PG8_LDA(dst, b, h) do { _Pragma("unroll") for (int m = 0; m < 4; ++m) _Pragma("unroll") for (int k = 0; k < 2; ++k) dst[m][k] = *(const LAS bf16x8*)(lds + PG8_SA(b, h) + aoff + m * 2048 + k * 1024); } while (0)
#define PG8_LDB(dst, b, h) do { _Pragma("unroll") for (int n = 0; n < 2; ++n) _Pragma("unroll") for (int k = 0; k < 2; ++k) dst[n][k] = *(const LAS bf16x8*)(lds + PG8_SB(b, h) + boff + n * 2048 + k * 1024); } while (0)
#define PG8_MMA(ai, bj, At, Bt) do { __builtin_amdgcn_s_setprio(1); _Pragma("unroll") for (int m = 0; m < 4; ++m) _Pragma("unroll") for (int n = 0; n < 2; ++n) _Pragma("unroll") for (int k = 0; k < 2; ++k) \
        acc[ai][bj][m][n] = __builtin_amdgcn_mfma_f32_16x16x32_bf16(Bt[n][k], At[m][k], acc[ai][bj][m][n], 0, 0, 0); __builtin_amdgcn_s_setprio(0); } while (0)
#define PG8_WAIT_V(n) asm volatile("s_waitcnt vmcnt(" #n ")" ::: "memory")
#define PG8_WAIT_L(n) asm volatile("s_waitcnt lgkmcnt(" #n ")" ::: "memory")
#define PG8_BAR __builtin_amdgcn_s_barrier()
#define PG8_SCHED __builtin_amdgcn_sched_barrier(0)
#define PG8_AOFF(u, dst) do { _Pragma("unroll") for (int _h = 0; _h < 2; ++_h) _Pragma("unroll") for (int _i = 0; _i < 2; ++_i) { \
        int _R, _C; stage_rc(tid * 16 + _i * 8192, _R, _C); dst[_h * 2 + _i] = (S.arow(u, _h * HALF + _R) * (unsigned)K + (unsigned)_C) * 2u; } } while (0)
    Unit cur, nxt; int ui = 0;
    if (!S.next(0, cur)) return;
    f32x4 acc[2][2][4][2];
#pragma unroll
    for (int a = 0; a < 2; ++a)
#pragma unroll
        for (int b = 0; b < 2; ++b)
#pragma unroll
            for (int m = 0; m < 4; ++m)
#pragma unroll
                for (int n = 0; n < 2; ++n) acc[a][b][m][n] = (f32x4){0.f, 0.f, 0.f, 0.f};
    bf16x8 At[4][2], B0[2][2], B1[2][2];
    unsigned offc[4] = {0u, 0u, 0u, 0u}, offn[4] = {0u, 0u, 0u, 0u};
    volatile LAS unsigned* onx = (volatile LAS unsigned*)(lds + OFFN_OFF) + tid * 4;
    if constexpr (GATHER) PG8_AOFF(cur, offc);
    const char* cA = GATHER ? Ab : S.aptr(cur, Ab);
    const char* cB = S.bptr(cur);
    PG8_STAGE(PG8_SB(0, 0), cB, voffB); PG8_STAGE(PG8_SB(0, 1), cB + hstep, voffB); PG8_STAGEA(PG8_SA(0, 0), cA, 0, offc, 0); PG8_STAGEA(PG8_SA(0, 1), cA, 0, offc, 1);
    if (wr == 1) PG8_BAR;
    PG8_WAIT_V(2); PG8_BAR;
    PG8_STAGE(PG8_SB(1, 0), cB + kstep, voffB); PG8_STAGEA(PG8_SA(1, 0), cA + kstep, kstep, offc, 0); PG8_STAGE(PG8_SB(1, 1), cB + hstep + kstep, voffB);
    PG8_WAIT_V(6); PG8_BAR;
    for (;;) {
        const bool has_next = S.next(ui + 1, nxt);
        const char* nA = cA; const char* nB = cB;
        if (has_next) { nB = S.bptr(nxt); if constexpr (!GATHER) nA = S.aptr(nxt, Ab);
            if constexpr (GATHER) { unsigned tmp[4]; PG8_AOFF(nxt, tmp);
#pragma unroll
                for (int j = 0; j < 4; ++j) onx[j] = tmp[j]; } }
#pragma unroll 1
        for (int t = 0; t < nt; t += 2) {
            const bool last = (t == nt - 2);
            unsigned ldsw = ldsw0; asm volatile("" : "+s"(ldsw));
            const char* a1 = cA + (size_t)(t + 1) * kstep; const size_t k1 = (size_t)(t + 1) * kstep;
            const char* a2 = last ? nA : cA + (size_t)(t + 2) * kstep; const size_t k2 = last ? 0 : (size_t)(t + 2) * kstep;
            const char* b2 = last ? nB : cB + (size_t)(t + 2) * kstep;
            const char* a3 = a2 + kstep; const char* b3 = b2 + kstep; const size_t k3 = k2 + kstep;
            if constexpr (GATHER) {
#pragma unroll
                for (int j = 0; j < 4; ++j) offn[j] = offc[j];
                if (last && has_next) {
#pragma unroll
                    for (int j = 0; j < 4; ++j) offn[j] = onx[j];
                }
            }
            PG8_LDB(B0, 0, 0); PG8_LDB(B1, 0, 1); PG8_SCHED; PG8_LDA(At, 0, 0); PG8_STAGEA(PG8_SA(1, 1), a1, k1, offc, 1);
            PG8_WAIT_V(8); PG8_WAIT_L(0); PG8_BAR; PG8_MMA(0, 0, At, B0); PG8_MMA(0, 1, At, B1); PG8_BAR; PG8_SCHED;
            PG8_LDA(At, 0, 1); PG8_STAGE(PG8_SB(0, 0), b2, voffB); PG8_STAGE(PG8_SB(0, 1), b2 + hstep, voffB); PG8_STAGEA(PG8_SA(0, 0), a2, k2, offn, 0);
            PG8_WAIT_V(8); PG8_WAIT_L(0); PG8_BAR; PG8_MMA(1, 0, At, B0); PG8_MMA(1, 1, At, B1); PG8_BAR; PG8_SCHED;
            PG8_LDB(B0, 1, 0); PG8_LDB(B1, 1, 1); PG8_SCHED; PG8_LDA(At, 1, 0); PG8_STAGEA(PG8_SA(0, 1), a2, k2, offn, 1);
            PG8_WAIT_V(8); PG8_WAIT_L(0); PG8_BAR; PG8_MMA(0, 0, At, B0); PG8_MMA(0, 1, At, B1); PG8_BAR; PG8_SCHED;
            PG8_LDA(At, 1, 1); PG8_STAGE(PG8_SB(1, 0), b3, voffB); PG8_STAGE(PG8_SB(1, 1), b3 + hstep, voffB); PG8_STAGEA(PG8_SA(1, 0), a3, k3, offn, 0);
            PG8_WAIT_V(8); PG8_WAIT_L(0); PG8_BAR; PG8_MMA(1, 0, At, B0); PG8_MMA(1, 1, At, B1); PG8_BAR; PG8_SCHED;
        }
        if (wr == 0) PG8_BAR;
        E(acc, cur, wr, wc, fr, fq);
        if (!has_next) break;
#pragma unroll
        for (int a = 0; a < 2; ++a)
#pragma unroll
            for (int b = 0; b < 2; ++b)
#pragma unroll
                for (int m = 0; m < 4; ++m)
#pragma unroll
                    for (int n = 0; n < 2; ++n) acc[a][b][m][n] = (f32x4){0.f, 0.f, 0.f, 0.f};
        cur = nxt; cA = nA; cB = nB; ++ui;
        if constexpr (GATHER) {
#pragma unroll
            for (int j = 0; j < 4; ++j) offc[j] = onx[j];
        }
        if (wr == 1) PG8_BAR;
    }
    PG8_WAIT_V(0);
    PG8_BAR;
#undef PG8_SA
#undef PG8_SB
#undef PG8_STAGE
#undef PG8_STAGEA
#undef PG8_LDA
#undef PG8_LDB
#undef PG8_MMA
#undef PG8_WAIT_V
#undef PG8_WAIT_L
#undef PG8_BAR
#undef PG8_SCHED
#undef PG8_AOFF
}
}

struct DenseUnit { int pm, pn; };
struct DenseSched {
    typedef DenseUnit Unit;
    int nM, nN, nwg, G, c; const bf16_t* Bt; int K;
    __device__ __forceinline__ void init(int M, int N, int K_, const bf16_t* Bt_, int G_, int c_) { nM = M / 256; nN = N / 256; nwg = nM * nN; G = G_; c = c_; Bt = Bt_; K = K_; }
    __device__ __forceinline__ bool next(int i, Unit& u) const {
        const long L = (long)i * G + c; if (L >= nwg) return false;
        int wgid = (int)L; { const int q = nwg / 8, r = nwg % 8, xcd = wgid % 8, off = wgid / 8; wgid = (xcd < r ? xcd * (q + 1) : r * (q + 1) + (xcd - r) * q) + off; }
        const int nig = 8 * nN, gid = wgid / nig, fm = gid * 8, gsz = (nM - fm) < 8 ? (nM - fm) : 8;
        u.pm = fm + ((wgid % nig) % gsz); u.pn = (wgid % nig) / gsz; return true;
    }
    static constexpr bool GATHER = false;
    __device__ __forceinline__ unsigned arow(const Unit& u, int r) const { return (unsigned)(u.pm * 256 + r); }
    __device__ __forceinline__ const char* aptr(const Unit& u, const char* Ab) const { return Ab + (size_t)u.pm * 256 * K * 2; }
    __device__ __forceinline__ const char* bptr(const Unit& u) const { return (const char*)(Bt + (size_t)u.pn * 256 * K); }
};
struct MoeUnit { int e, tile, rt, pn, cnt; };
template <bool GATHER_>
struct MoeSched {
    typedef MoeUnit Unit;
    static constexpr bool GATHER = GATHER_;
    const volatile LAS unsigned* tp;
    const volatile LAS unsigned* cnt;
    const volatile LAS unsigned* te;
    const int* list;
    const bf16_t* Bt; size_t bstride_e; int K; int npn, lognpn; int G, c;
    __device__ __forceinline__ bool next(int i, Unit& u) const {
        const int L = i * G + c; const int tile = L >> lognpn; const int ntile = __builtin_amdgcn_readfirstlane((int)tp[32]);
        if (tile >= ntile) return false;
        u.e = __builtin_amdgcn_readfirstlane((int)te[tile]); u.tile = tile; u.rt = tile - __builtin_amdgcn_readfirstlane((int)tp[u.e]);
        u.cnt = __builtin_amdgcn_readfirstlane((int)cnt[u.e]); u.pn = L & (npn - 1); return true;
    }
    __device__ __forceinline__ const char* aptr(const Unit& u, const char* Ab) const { return Ab + (size_t)u.tile * 256 * K * 2; }
    __device__ __forceinline__ unsigned arow(const Unit& u, int r) const {
        const int slot = u.rt * 256 + r;
        return (slot < u.cnt) ? (unsigned)list[(size_t)u.e * NT + slot] : 0u;
    }
    __device__ __forceinline__ const char* bptr(const Unit& u) const { return (const char*)(Bt + (size_t)u.e * bstride_e + (size_t)u.pn * 256 * K); }
};

struct EpiProj {
    static constexpr bool PERM = true;
    bf16_t* O; float* ksq;
    __device__ __forceinline__ void operator()(const f32x4 (&acc)[2][2][4][2], const DenseUnit& u, int wr, int wc, int fr, int fq) const {
        const int row0 = u.pm * 256 + wr * 64 + fr, col0 = u.pn * 256 + wc * 32 + 8 * fq;
        const bool qk = (u.pn >= 4 && u.pn < 8);
#pragma unroll
        for (int ai = 0; ai < 2; ++ai)
#pragma unroll
            for (int m = 0; m < 4; ++m) { const int row = row0 + ai * 128 + m * 16; bf16_t* rowp = O + (size_t)row * DIN + col0;
#pragma unroll
                for (int bj = 0; bj < 2; ++bj) { const f32x4 v0 = acc[ai][bj][m][0], v1 = acc[ai][bj][m][1];
                    u32x4 w; w.x = pk2(v0[0], v0[1]); w.y = pk2(v0[2], v0[3]); w.z = pk2(v1[0], v1[1]); w.w = pk2(v1[2], v1[3]);
                    *(u32x4*)(rowp + bj * 128) = w;
                    if (qk) { float ss = (v0[0] * v0[0] + v0[1] * v0[1]) + (v0[2] * v0[2] + v0[3] * v0[3]) + (v1[0] * v1[0] + v1[1] * v1[1]) + (v1[2] * v1[2] + v1[3] * v1[3]);
                        ss += __shfl_xor(ss, 16); ss += __shfl_xor(ss, 32);
                        if (fq == 0) ksq[((size_t)row * 8 + (u.pn - 4) * 2 + bj) * 4 + wc] = ss; } } }
    }
};
struct EpiOut {
    static constexpr bool PERM = true;
    bf16_t* X; const float* gate;
    __device__ __forceinline__ void operator()(const f32x4 (&acc)[2][2][4][2], const DenseUnit& u, int wr, int wc, int fr, int fq) const {
        const int row0 = u.pm * 256 + wr * 64 + fr, col0 = u.pn * 256 + wc * 32 + 8 * fq;
        const int b = (u.pm * 256) / SEQ;
        f32x4 gv[2][2];
#pragma unroll
        for (int bj = 0; bj < 2; ++bj)
#pragma unroll
            for (int n = 0; n < 2; ++n) gv[bj][n] = *(const f32x4*)(gate + (size_t)b * 6 * DM + col0 + bj * 128 + n * 4);
#pragma unroll
        for (int ai = 0; ai < 2; ++ai)
#pragma unroll
            for (int m = 0; m < 4; ++m) { bf16_t* rowp = X + (size_t)(row0 + ai * 128 + m * 16) * DM + col0;
#pragma unroll
                for (int bj = 0; bj < 2; ++bj) { u32x4* p = (u32x4*)(rowp + bj * 128); const u32x4 w = *p;
                    const f32x4 a0 = gv[bj][0] * acc[ai][bj][m][0], a1 = gv[bj][1] * acc[ai][bj][m][1];
                    u32x4 o; o.x = pk2(bflo(w.x) + a0[0], bfhi(w.x) + a0[1]); o.y = pk2(bflo(w.y) + a0[2], bfhi(w.y) + a0[3]);
                    o.z = pk2(bflo(w.z) + a1[0], bfhi(w.z) + a1[1]); o.w = pk2(bflo(w.w) + a1[2], bfhi(w.w) + a1[3]); *p = o; }
                asm volatile("" ::: "memory"); }
    }
};
struct EpiAct {
    static constexpr bool PERM = true;
    bf16_t* O;
    __device__ __forceinline__ void operator()(const f32x4 (&acc)[2][2][4][2], const MoeUnit& u, int wr, int wc, int fr, int fq) const {
        const int row0 = u.tile * 256 + wr * 64 + fr, col0 = u.pn * 128 + wc * 32 + 8 * fq;
#pragma unroll
        for (int ai = 0; ai < 2; ++ai)
#pragma unroll
            for (int m = 0; m < 4; ++m) { bf16_t* rowp = O + (size_t)(row0 + ai * 128 + m * 16) * DE + col0;
                float r[8];
#pragma unroll
                for (int n = 0; n < 2; ++n)
#pragma unroll
                    for (int j = 0; j < 4; ++j) r[n * 4 + j] = silu_f(acc[ai][0][m][n][j]) * acc[ai][1][m][n][j];
                u32x4 w; w.x = pk2(r[0], r[1]); w.y = pk2(r[2], r[3]); w.z = pk2(r[4], r[5]); w.w = pk2(r[6], r[7]);
                *(u32x4*)rowp = w; }
    }
};
__device__ __forceinline__ unsigned pk4_fp8(float a, float b, float c, float d) {
    a = __builtin_fminf(__builtin_fmaxf(a, -448.f), 448.f); b = __builtin_fminf(__builtin_fmaxf(b, -448.f), 448.f);
    c = __builtin_fminf(__builtin_fmaxf(c, -448.f), 448.f); d = __builtin_fminf(__builtin_fmaxf(d, -448.f), 448.f);
    int p = 0; p = __builtin_amdgcn_cvt_pk_fp8_f32(a, b, p, false); p = __builtin_amdgcn_cvt_pk_fp8_f32(c, d, p, true); return (unsigned)p; }
struct EpiY {
    static constexpr bool PERM = true;
    unsigned char* O;
    __device__ __forceinline__ void operator()(const f32x4 (&acc)[2][2][4][2], const MoeUnit& u, int wr, int wc, int fr, int fq) const {
        const int row0 = u.tile * 256 + wr * 64 + fr, col0 = u.pn * 256 + wc * 32 + 8 * fq;
#pragma unroll
        for (int ai = 0; ai < 2; ++ai)
#pragma unroll
            for (int m = 0; m < 4; ++m) { unsigned char* rowp = O + (size_t)(row0 + ai * 128 + m * 16) * DM + col0;
#pragma unroll
                for (int bj = 0; bj < 2; ++bj) { const f32x4 v0 = acc[ai][bj][m][0], v1 = acc[ai][bj][m][1];
                    u32x2 w; w.x = pk4_fp8(v0[0], v0[1], v0[2], v0[3]); w.y = pk4_fp8(v1[0], v1[1], v1[2], v1[3]);
                    *(u32x2*)(rowp + bj * 128) = w; } }
    }
};

struct Args { const float* in[22]; float* out; unsigned char* ws; int ph_lo, ph_hi; };
struct Frame {
    LAS unsigned char* lds; volatile LAS unsigned* MISC; unsigned* ctl;
    int tid, lane, wave, vcu, G, gw, NGW;
};

typedef const __attribute__((address_space(4))) Args CArgs;
struct ArgV { CArgs* p;
    __device__ __forceinline__ const float* in(int i) const { return p->in[i]; }
    __device__ __forceinline__ unsigned char* ws() const { return p->ws; }
    __device__ __forceinline__ float* out() const { return p->out; }
    __device__ __forceinline__ int ph_lo() const { return p->ph_lo; }
    __device__ __forceinline__ int ph_hi() const { return p->ph_hi; } };
__device__ __forceinline__ ArgV get_args() { CArgs* p = (CArgs*)__builtin_amdgcn_kernarg_segment_ptr(); asm volatile("" : "+s"(p)); ArgV a; a.p = p; return a; }
__device__ __forceinline__ void transpose_item(const float* src, int N, int k0, int n0, bf16_t* dst, int Kd, int drow0, LAS float* scr, int lane) {
#pragma unroll 4
    for (int i = 0; i < 16; ++i) { const int kk = 4 * i + (lane >> 4), c4 = (lane & 15) * 4;
        const f32x4 v = *(const f32x4*)(src + (size_t)(k0 + kk) * N + n0 + c4);
        LAS float* s = scr + kk * 65 + c4; s[0] = v[0]; s[1] = v[1]; s[2] = v[2]; s[3] = v[3]; }
    asm volatile("s_waitcnt lgkmcnt(0)" ::: "memory");
#pragma unroll 2
    for (int i = 0; i < 8; ++i) { const int cid = lane + 64 * i, n = cid >> 3, c = cid & 7; const LAS float* s = scr + (8 * c) * 65 + n;
        u32x4 o; o.x = pk2(s[0 * 65], s[1 * 65]); o.y = pk2(s[2 * 65], s[3 * 65]); o.z = pk2(s[4 * 65], s[5 * 65]); o.w = pk2(s[6 * 65], s[7 * 65]);
        *(u32x4*)(dst + (size_t)(drow0 + n) * Kd + k0 + 8 * c) = o; }
    asm volatile("s_waitcnt lgkmcnt(0)" ::: "memory");
}

__device__ __forceinline__ void phase_modpart(Frame& F, const float* c, const float* w_mod, float* modpart) {
    int vcu_ = F.vcu, gw_ = F.gw; asm volatile("" : "+s"(vcu_), "+s"(gw_)); (void)vcu_; (void)gw_;
    const int tid_ = fresh_tid(), lane_ = tid_ & 63; (void)tid_; (void)lane_;
    LAS float* red = (LAS float*)F.lds;
    for (int item = vcu_; item < 256; item += F.G) {
        const int cg = item & 63, ks = item >> 6;
        const int cq = tid_ % 48, rg = tid_ / 48;
        float a[4][4];
#pragma unroll
        for (int b = 0; b < 4; ++b)
#pragma unroll
            for (int j = 0; j < 4; ++j) a[b][j] = 0.f;
        if (rg < 10) {
            for (int k = ks * 512 + rg; k < ks * 512 + 512; k += 10) {
                const f32x4 w = *(const f32x4*)(w_mod + (size_t)k * NMOD + cg * 192 + cq * 4);
#pragma unroll
                for (int b = 0; b < 4; ++b) { const float s = silu_f(c[b * DM + k]);
#pragma unroll
                    for (int j = 0; j < 4; ++j) a[b][j] += s * w[j]; }
            }
#pragma unroll
            for (int b = 0; b < 4; ++b)
#pragma unroll
                for (int j = 0; j < 4; ++j) red[(rg * 4 + b) * 192 + cq * 4 + j] = a[b][j];
        }
        __syncthreads();
        for (int o = tid_; o < 4 * 192; o += 512) { const int b = o / 192, col = o % 192; float s = 0.f;
            for (int r = 0; r < 10; ++r) s += red[(r * 4 + b) * 192 + col];
            modpart[((size_t)ks * 4 + b) * NMOD + cg * 192 + col] = s; }
        __syncthreads();
    }
}

__device__ __forceinline__ void phase_prep(Frame& F, const ArgV A) {
    int vcu_ = F.vcu, gw_ = F.gw; asm volatile("" : "+s"(vcu_), "+s"(gw_)); (void)vcu_; (void)gw_;
    const int tid_ = fresh_tid(), lane_ = tid_ & 63; (void)tid_; (void)lane_;
    const float* modpart = (const float*)(A.ws() + WS_MODPART); float* modv = (float*)(A.ws() + WS_MODV);
    const float *b_mod = A.in(3), *mod_layer = A.in(4), *norm1_g = A.in(5), *norm2_g = A.in(14);
    for (int idx = vcu_ * 512 + tid_; idx < NL * NB * 6 * DM; idx += F.G * 512) {
        const int col = idx % DM, which = (idx / DM) % 6, b = (idx / (6 * DM)) % NB, l = idx / (6 * DM * NB);
        const int n = which * DM + col;
        float m = b_mod[n] + mod_layer[l * NMOD + n];
#pragma unroll
        for (int ks = 0; ks < 4; ++ks) m += modpart[((size_t)ks * 4 + b) * NMOD + n];
        float o = m;
        if (which == 1) o = norm1_g[l * DM + col] * (1.f + m);
        if (which == 4) o = norm2_g[l * DM + col] * (1.f + m);
        modv[idx] = o;
    }
    {
        const float *w_group = A.in(15), *w_route = A.in(17); bf16_t* WrT = (bf16_t*)(A.ws() + WS_WRT);
        for (int idx = vcu_ * 512 + tid_; idx < NL * 64 * DM; idx += F.G * 512) {
            const int k = idx % DM, rho = (idx / DM) % 64, l = idx / (64 * DM);
            float val = 0.f;
            if (rho < 32) { const int h = (rho >> 2) & 1, rp = (rho & 3) + 4 * (rho >> 3), e = (2 * h + (rp >> 3)) * 8 + (rp & 7); val = w_route[((size_t)l * DM + k) * 32 + e]; }
            else if (rho < 40) val = w_group[((size_t)l * DM + k) * 4 + ((rho - 32) & 3)];
            WrT[idx] = (bf16_t)f2bf(val);
        }
    }
    {
        const float* gm_ws = A.in(8); bf16_t* Wgm = (bf16_t*)(A.ws() + WS_WGM);
        for (int idx = vcu_ * 512 + tid_; idx < NL * 4 * 128 * 128; idx += F.G * 512) { const int p = idx & 127, t = (idx >> 7) & 127; Wgm[idx] = (p <= t) ? (bf16_t)f2bf(gm_ws[idx]) : (bf16_t)0; }
    }
    LAS float* scr = (LAS float*)(F.lds + F.wave * 16640);
    constexpr int I_IN = NL * 32 * 40, I_OUT = NL * 16 * 32, I_GU = NL * NE * 2 * 32 * 4, I_DN = NL * NE * 4 * 32;
    const float *w_in = A.in(6), *w_out = A.in(13), *w_gate = A.in(19), *w_up = A.in(20), *w_down = A.in(21);
    bf16_t* WinT = (bf16_t*)(A.ws() + WS_WINT); bf16_t* WoutT = (bf16_t*)(A.ws() + WS_WOUTT); bf16_t* WguT = (bf16_t*)(A.ws() + WS_WGUT); bf16_t* WdT = (bf16_t*)(A.ws() + WS_WDT);
    for (int it = gw_; it < I_IN + I_OUT + I_GU + I_DN; it += F.NGW) {
        int r = it;
        if (r < I_IN) { const int l = r / (32 * 40), q = r % (32 * 40), kb = q / 40, nb = q % 40;
            transpose_item(w_in + (size_t)l * DM * DIN, DIN, 64 * kb, 64 * nb, WinT + (size_t)l * DIN * DM, DM, 64 * nb, scr, lane_); continue; }
        r -= I_IN;
        if (r < I_OUT) { const int l = r / (16 * 32), q = r % (16 * 32), kb = q / 32, nb = q % 32;
            transpose_item(w_out + (size_t)l * DMIX * DM, DM, 64 * kb, 64 * nb, WoutT + (size_t)l * DM * DMIX, DMIX, 64 * nb, scr, lane_); continue; }
        r -= I_OUT;
        if (r < I_GU) { const int le = r / 256, q = r % 256, up = q >> 7, kb = (q & 127) >> 2, nb = q & 3;
            const float* src = (up ? w_up : w_gate) + (size_t)le * DM * DE;
            const int n0 = 64 * nb, drow0 = 256 * (n0 >> 7) + (n0 & 127) + 128 * up;
            transpose_item(src, DE, 64 * kb, n0, WguT + (size_t)le * 512 * DM, DM, drow0, scr, lane_); continue; }
        r -= I_GU;
        { const int le = r / 128, q = r % 128, kb = q >> 5, nb = q & 31;
            transpose_item(w_down + (size_t)le * DE * DM, DM, 64 * kb, 64 * nb, WdT + (size_t)le * DM * DE, DE, 64 * nb, scr, lane_); }
    }
}

__device__ __forceinline__ void build_tiles(Frame& F, int lc) {
    const int tid_ = fresh_tid(), lane_ = tid_ & 63; (void)tid_; (void)lane_;
    __syncthreads();
    if (tid_ < 32) { const unsigned n = __hip_atomic_load(F.ctl + CW_CNT + (lc * 32 + tid_) * 64, RLX_AGENT); F.MISC[64 + tid_] = n; }
    __syncthreads();
    if (tid_ == 0) { unsigned p = 0; for (int e = 0; e < 32; ++e) { F.MISC[16 + e] = p; p += (F.MISC[64 + e] + 255u) >> 8; } F.MISC[16 + 32] = p; }
    __syncthreads();
    if (tid_ < 32) { volatile LAS unsigned* te = (volatile LAS unsigned*)(F.lds + TILE_E_OFF); const unsigned a = F.MISC[16 + tid_], b = F.MISC[17 + tid_]; for (unsigned t = a; t < b; ++t) te[t] = (unsigned)tid_; }
    __syncthreads();
}

template <int MODE>
__device__ __forceinline__ void phase_norm1(Frame& F, const ArgV A, int l) {
    int vcu_ = F.vcu; asm volatile("" : "+s"(vcu_));
    const int tid_ = fresh_tid(), lane_ = tid_ & 63; (void)tid_;
    const float* modv = (const float*)(A.ws() + WS_MODV);
    const unsigned char* yslot = (const unsigned char*)(A.ws() + WS_YSLOT); bf16_t* hout = (bf16_t*)A.out(); bf16_t* xb = (bf16_t*)(A.ws() + WS_XB);
    const float* xin = A.in(0); float* outf = A.out();
    const int* tok = (const int*)(A.ws() + WS_TOK);
    if (MODE != 0) build_tiles(F, l - 1);
    for (int blk = vcu_; blk < NT / 128; blk += F.G) {
        const int b = (blk * 128) / SEQ;
        const float* mA_ = modv + ((size_t)((MODE != 2 ? l : 0) * NB + b) * 6 + 1) * DM;
        const float* mS_ = modv + ((size_t)((MODE != 2 ? l : 0) * NB + b) * 6 + 0) * DM;
        const float* mG_ = modv + ((size_t)((MODE != 0 ? l - 1 : 0) * NB + b) * 6 + 5) * DM;
        int s0v = 0, s1v = 0; float w0v = 0.f, w1v = 0.f;
        if (MODE != 0) { const int rr = blk * 128 + F.wave * 16 + (lane_ & 15); const int* tr = tok + (size_t)rr * 8;
            const int e0 = tr[0], e1 = tr[1], p0 = tr[2], p1 = tr[3]; w0v = __builtin_bit_cast(float, tr[4]); w1v = __builtin_bit_cast(float, tr[5]);
            s0v = (int)F.MISC[16 + e0] * 256 + p0; s1v = (int)F.MISC[16 + e1] * 256 + p1; }
#pragma unroll 1
        for (int i = 0; i < 16; i += 2) {
            const int row = blk * 128 + F.wave * 16 + i;
            const float *mA = mA_, *mS = mS_, *mG = mG_;
            asm volatile("" : "+s"(mA), "+s"(mS), "+s"(mG));
            f32x4 v[2][8];
            if (MODE == 0) {
#pragma unroll
                for (int r = 0; r < 2; ++r) { const f32x4* xr = (const f32x4*)(xin + (size_t)(row + r) * DM) + lane_;
#pragma unroll
                    for (int j = 0; j < 8; ++j) v[r][j] = xr[64 * j]; } }
            else {
                u32x2 xw[2][8]; unsigned ya[2][8], yc[2][8]; float cw0[2], cw1[2];
#pragma unroll
                for (int r = 0; r < 2; ++r) { const int s0 = __shfl(s0v, i + r), s1 = __shfl(s1v, i + r); cw0[r] = __shfl(w0v, i + r); cw1[r] = __shfl(w1v, i + r);
                    const u32x2* xr = (const u32x2*)(xb + (size_t)(row + r) * DM) + lane_;
                    const unsigned* y0 = (const unsigned*)(yslot + (size_t)s0 * DM) + lane_; const unsigned* y1 = (const unsigned*)(yslot + (size_t)s1 * DM) + lane_;
#pragma unroll
                    for (int j = 0; j < 8; ++j) { xw[r][j] = xr[64 * j]; ya[r][j] = y0[64 * j]; yc[r][j] = y1[64 * j]; } }
#pragma unroll
                for (int j = 0; j < 8; ++j) { const f32x4 g = *((const f32x4*)mG + lane_ + 64 * j);
#pragma unroll
                    for (int r = 0; r < 2; ++r) { const u32x2 w = xw[r][j]; const int a = (int)ya[r][j], c = (int)yc[r][j]; const float w0 = cw0[r], w1 = cw1[r];
                        v[r][j][0] = bflo(w.x) + g[0] * (w0 * __builtin_amdgcn_cvt_f32_fp8(a, 0) + w1 * __builtin_amdgcn_cvt_f32_fp8(c, 0));
                        v[r][j][1] = bfhi(w.x) + g[1] * (w0 * __builtin_amdgcn_cvt_f32_fp8(a, 1) + w1 * __builtin_amdgcn_cvt_f32_fp8(c, 1));
                        v[r][j][2] = bflo(w.y) + g[2] * (w0 * __builtin_amdgcn_cvt_f32_fp8(a, 2) + w1 * __builtin_amdgcn_cvt_f32_fp8(c, 2));
                        v[r][j][3] = bfhi(w.y) + g[3] * (w0 * __builtin_amdgcn_cvt_f32_fp8(a, 3) + w1 * __builtin_amdgcn_cvt_f32_fp8(c, 3)); } }
            }
            if (MODE == 2) {
#pragma unroll
                for (int r = 0; r < 2; ++r) { f32x4* xo = (f32x4*)(outf + (size_t)(row + r) * DM) + lane_;
#pragma unroll
                    for (int j = 0; j < 8; ++j) xo[64 * j] = v[r][j]; } }
            else {
                float ss[2] = {0.f, 0.f};
#pragma unroll
                for (int r = 0; r < 2; ++r) { u32x2* xo = (u32x2*)(xb + (size_t)(row + r) * DM) + lane_;
#pragma unroll
                    for (int j = 0; j < 8; ++j) { u32x2 o; o.x = pk2(v[r][j][0], v[r][j][1]); o.y = pk2(v[r][j][2], v[r][j][3]); xo[64 * j] = o;
                        v[r][j] = (f32x4){bflo(o.x), bfhi(o.x), bflo(o.y), bfhi(o.y)};
                        ss[r] += (v[r][j][0] * v[r][j][0] + v[r][j][1] * v[r][j][1]) + (v[r][j][2] * v[r][j][2] + v[r][j][3] * v[r][j][3]); } }
#pragma unroll
                for (int o = 1; o < 64; o <<= 1) { ss[0] += __shfl_xor(ss[0], o); ss[1] += __shfl_xor(ss[1], o); }
                const float rstd0 = 1.f / sqrtf(ss[0] * (1.f / DM) + EPS), rstd1 = 1.f / sqrtf(ss[1] * (1.f / DM) + EPS);
                u32x2* ho0 = (u32x2*)(hout + (size_t)row * DM) + lane_; u32x2* ho1 = ho0 + DM / 4;
#pragma unroll
                for (int j = 0; j < 8; ++j) { const f32x4 a = *((const f32x4*)mA + lane_ + 64 * j), sh = *((const f32x4*)mS + lane_ + 64 * j);
                    u32x2 o; o.x = pk2(v[0][j][0] * rstd0 * a[0] + sh[0], v[0][j][1] * rstd0 * a[1] + sh[1]); o.y = pk2(v[0][j][2] * rstd0 * a[2] + sh[2], v[0][j][3] * rstd0 * a[3] + sh[3]); ho0[64 * j] = o;
                    u32x2 p; p.x = pk2(v[1][j][0] * rstd1 * a[0] + sh[0], v[1][j][1] * rstd1 * a[1] + sh[1]); p.y = pk2(v[1][j][2] * rstd1 * a[2] + sh[2], v[1][j][3] * rstd1 * a[3] + sh[3]); ho1[64 * j] = p; }
            }
        }
    }
}

__device__ __forceinline__ int crow(int r, int h) { return (r & 3) + 8 * (r >> 2) + 4 * h; }
__device__ __forceinline__ unsigned off_b(unsigned row, unsigned ch) { return 256u * row + 16u * (ch ^ (((row & 3u) << 2) | ((row >> 2) & 3u))); }
typedef short s16x4 __attribute__((ext_vector_type(4)));
__device__ __forceinline__ s16x4 vtr(const LAS unsigned char* p) { return __builtin_bit_cast(s16x4, __builtin_amdgcn_ds_read_tr16_b64_v4i16((LAS s16x4*)p)); }
__device__ __forceinline__ bf16x8 pack8(float a0, float a1, float a2, float a3, float a4, float a5, float a6, float a7) {
    u32x4 p; p.x = pk2(a0, a1); p.y = pk2(a2, a3); p.z = pk2(a4, a5); p.w = pk2(a6, a7); return __builtin_bit_cast(bf16x8, p); }
__device__ __forceinline__ float gelu_fast(float v) {
    const float av = __builtin_fabsf(v), t = __builtin_amdgcn_rcpf(av * 0.2316418882f + 1.0f);
    float q = t * 0.5307027145f + (-0.7265760135f); q = q * t + 0.7107068705f; q = q * t + (-0.142248368f); q = q * t + 0.127414796f; q = q * t;
    const float e = __builtin_amdgcn_exp2f((v * v) * (-0.72134752044f));
    const float m = v * (q * e);
    return v < 0.f ? m : v - m;
}
__device__ __forceinline__ void phase_gmlp(Frame& F, const ArgV A, int l) {
    int vcu_ = F.vcu, gw_ = F.gw; asm volatile("" : "+s"(vcu_), "+s"(gw_)); (void)vcu_; (void)gw_;
    const int tid_ = fresh_tid(), lane = tid_ & 63, r32 = lane & 31, hh = lane >> 5;
    const bf16_t* proj = (const bf16_t*)(A.ws() + WS_PROJ); bf16_t* ymix = (bf16_t*)(A.ws() + WS_YMIX);
    const float *gm_norm_g = A.in(7) + l * 512, *gm_bs = A.in(9) + l * 512, *out_norm_g = A.in(12) + l * DMIX;
    const bf16_t* Wgm = (const bf16_t*)(A.ws() + WS_WGM) + (size_t)l * 4 * 128 * 128;
    LAS unsigned char* vimg = F.lds;
    LAS float* red = (LAS float*)(F.lds + 32768);
    const unsigned blk16 = (lane >> 4) & 1, tq = (lane & 15) >> 2, tp = lane & 3;
    const int tb = F.wave >> 1, kh = F.wave & 1;
    for (int u = vcu_; u < NT / 128 * 4; u += F.G) {
        const int g = u & 3, ch = u >> 2, row0 = ch * 128;
        {
            const int p = tid_ >> 2, seg = tid_ & 3;
            const u32x4* vp = (const u32x4*)(proj + (size_t)(row0 + p) * DIN + 512 + g * 128 + seg * 32);
            float x[32]; float ss = 0.f;
#pragma unroll
            for (int c = 0; c < 4; ++c) { const u32x4 w = vp[c];
                x[c * 8 + 0] = bflo(w.x); x[c * 8 + 1] = bfhi(w.x); x[c * 8 + 2] = bflo(w.y); x[c * 8 + 3] = bfhi(w.y);
                x[c * 8 + 4] = bflo(w.z); x[c * 8 + 5] = bfhi(w.z); x[c * 8 + 6] = bflo(w.w); x[c * 8 + 7] = bfhi(w.w); }
#pragma unroll
            for (int j = 0; j < 32; ++j) { x[j] = gelu_fast(x[j]); ss += x[j] * x[j]; }
            ss += __shfl_xor(ss, 1); ss += __shfl_xor(ss, 2);
            const float rv = 1.f / sqrtf(ss * (1.f / 128.f) + EPS);
            const float* gn = gm_norm_g + g * 128 + seg * 32;
#pragma unroll
            for (int c = 0; c < 4; ++c) { const f32x4 ga = *(const f32x4*)(gn + 8 * c), gb = *(const f32x4*)(gn + 8 * c + 4);
                *(LAS bf16x8*)(vimg + off_b((unsigned)p, (unsigned)(4 * seg + c))) = pack8(x[8 * c] * rv * ga[0], x[8 * c + 1] * rv * ga[1], x[8 * c + 2] * rv * ga[2], x[8 * c + 3] * rv * ga[3],
                                                                                         x[8 * c + 4] * rv * gb[0], x[8 * c + 5] * rv * gb[1], x[8 * c + 6] * rv * gb[2], x[8 * c + 7] * rv * gb[3]); }
        }
        __syncthreads();
        f32x16 acc[2];
#pragma unroll
        for (int kb = 0; kb < 2; ++kb)
#pragma unroll
            for (int q = 0; q < 16; ++q) acc[kb][q] = 0.f;
        const int t = 32 * tb + r32;
        const bf16x8* wrow = (const bf16x8*)(Wgm + ((size_t)g * 128 + t) * 128 + 8 * hh);
#pragma unroll 1
        for (int pb = 0; pb <= tb; ++pb) {
#pragma unroll
            for (int s2 = 0; s2 < 2; ++s2) {
                const bf16x8 bf = wrow[4 * pb + 2 * s2];
#pragma unroll
                for (int kb = 0; kb < 2; ++kb) {
                    const unsigned ra = (unsigned)(32 * pb + 16 * s2 + 8 * hh) + tq, rb = ra + 4u, cc = (unsigned)(2 * kh + kb);
                    const s16x4 lo4 = vtr(vimg + off_b(ra, 4u * cc + 2u * blk16 + (tp >> 1)) + 8u * (tp & 1));
                    const s16x4 hi4 = vtr(vimg + off_b(rb, 4u * cc + 2u * blk16 + (tp >> 1)) + 8u * (tp & 1));
                    const bf16x8 af = __builtin_shufflevector(lo4, hi4, 0, 1, 2, 3, 4, 5, 6, 7);
                    acc[kb] = __builtin_amdgcn_mfma_f32_32x32x16_bf16(af, bf, acc[kb], 0, 0, 0);
                }
            }
        }
        const float bias = gm_bs[g * 128 + t];
        float ss = 0.f;
#pragma unroll
        for (int kb = 0; kb < 2; ++kb)
#pragma unroll
            for (int g4 = 0; g4 < 4; ++g4) { const int k0 = 64 * kh + 32 * kb + 8 * g4 + 4 * hh;
                const u32x2 w = *(const u32x2*)(proj + (size_t)(row0 + t) * DIN + g * 128 + k0);
                const float u0 = gelu_fast(bflo(w.x)), u1 = gelu_fast(bfhi(w.x)), u2 = gelu_fast(bflo(w.y)), u3 = gelu_fast(bfhi(w.y));
                float y0 = u0 * (acc[kb][4 * g4] + bias), y1 = u1 * (acc[kb][4 * g4 + 1] + bias), y2 = u2 * (acc[kb][4 * g4 + 2] + bias), y3 = u3 * (acc[kb][4 * g4 + 3] + bias);
                acc[kb][4 * g4] = y0; acc[kb][4 * g4 + 1] = y1; acc[kb][4 * g4 + 2] = y2; acc[kb][4 * g4 + 3] = y3;
                ss += (y0 * y0 + y1 * y1) + (y2 * y2 + y3 * y3); }
        ss += __shfl_xor(ss, 32);
        if (hh == 0) red[F.wave * 32 + r32] = ss;
        __syncthreads();
        const float tot = red[(2 * tb) * 32 + r32] + red[(2 * tb + 1) * 32 + r32];
        const float ry = 1.f / sqrtf(tot * (1.f / 128.f) + EPS);
#pragma unroll
        for (int kb = 0; kb < 2; ++kb)
#pragma unroll
            for (int g4 = 0; g4 < 4; ++g4) { const int k0 = 64 * kh + 32 * kb + 8 * g4 + 4 * hh; const f32x4 og = *(const f32x4*)(out_norm_g + g * 128 + k0);
                u32x2 w; w.x = pk2(acc[kb][4 * g4] * ry * og[0], acc[kb][4 * g4 + 1] * ry * og[1]); w.y = pk2(acc[kb][4 * g4 + 2] * ry * og[2], acc[kb][4 * g4 + 3] * ry * og[3]);
                *(u32x2*)(ymix + (size_t)(row0 + t) * DMIX + g * 128 + k0) = w; }
        __syncthreads();
    }
}

__device__ __forceinline__ void phase_attn(Frame& F, const ArgV A, int l) {
    int vcu_ = F.vcu, gw_ = F.gw; asm volatile("" : "+s"(vcu_), "+s"(gw_)); (void)vcu_; (void)gw_;
    const int tid_ = fresh_tid(), lane = tid_ & 63, r32 = lane & 31, hh = lane >> 5;
    const bf16_t* proj = (const bf16_t*)(A.ws() + WS_PROJ); bf16_t* ymix = (bf16_t*)(A.ws() + WS_YMIX); const float* ksq = (const float*)(A.ws() + WS_KSQ);
    const float *qg = A.in(10) + l * 128, *kg = A.in(11) + l * 128, *out_norm_g = A.in(12) + l * DMIX;
    LAS unsigned char* vimg0 = F.lds + F.wave * 16512;
    LAS float* rkbuf = (LAS float*)(vimg0 + 16384);
    const float c2 = 1.4426950408889634f * 0.08838834764831845f;
    LAS float* gqk = (LAS float*)(F.lds + 8 * 16512);
    __syncthreads();
    if (tid_ < 128) gqk[tid_] = qg[tid_] * kg[tid_] * c2;
    __syncthreads();
    bf16x8 tf[2];
#pragma unroll
    for (int s = 0; s < 2; ++s)
#pragma unroll
        for (int j = 0; j < 8; ++j) tf[s][j] = ((16 * s + 8 * (j >> 2) + 4 * hh + (j & 3)) >= r32) ? (short)0x3F80 : (short)0;
    const unsigned blk16 = (lane >> 4) & 1, tq = (lane & 15) >> 2, tp = lane & 3;
    for (int u = gw_; u < NB * 4 * (SEQ / 32); u += F.NGW) {
        const int qb = u % (SEQ / 32), hd = (u / (SEQ / 32)) & 3, b = u / (4 * (SEQ / 32));
        const size_t rowq = (size_t)b * SEQ + qb * 32 + r32;
        bf16x8 qf[8];
        {
            const f32x4 qs4 = *(const f32x4*)(ksq + (rowq * 8 + hd) * 4);
            const float rq = 1.f / sqrtf(((qs4[0] + qs4[1]) + (qs4[2] + qs4[3])) * (1.f / 128.f) + EPS);
            const u32x4* qp = (const u32x4*)(proj + rowq * DIN + 1024 + hd * 128 + 8 * hh);
#pragma unroll
            for (int s = 0; s < 8; ++s) { const u32x4 w = qp[2 * s]; const int d0 = 16 * s + 8 * hh;
                const f32x4 ga = *(const LAS f32x4*)(gqk + d0), gb = *(const LAS f32x4*)(gqk + d0 + 4);
                qf[s] = pack8(bflo(w.x) * rq * ga[0], bfhi(w.x) * rq * ga[1], bflo(w.y) * rq * ga[2], bfhi(w.y) * rq * ga[3],
                              bflo(w.z) * rq * gb[0], bfhi(w.z) * rq * gb[1], bflo(w.w) * rq * gb[2], bfhi(w.w) * rq * gb[3]); }
        }
        f32x16 o[4];
#pragma unroll
        for (int db = 0; db < 4; ++db)
#pragma unroll
            for (int q = 0; q < 16; ++q) o[db][q] = 0.f;
        float R = 0.f;
        bf16x8 kf[8]; float rkv = 0.f; unsigned vbuf = 0u;
#define ATT_LOAD_TILE(kt_, buf_) do { const size_t rk0_ = (size_t)b * SEQ + (size_t)(kt_) * 32; \
            const bf16x8* kp_ = (const bf16x8*)(proj + (rk0_ + r32) * DIN + 1536 + hd * 128 + 8 * hh); \
            _Pragma("unroll") for (int s_ = 0; s_ < 8; ++s_) kf[s_] = kp_[2 * s_]; \
            _Pragma("unroll") for (int i_ = 0; i_ < 8; ++i_) { const unsigned row_ = 4u * i_ + (lane >> 4), ch_ = (lane & 15u) ^ (((row_ & 3u) << 2) | ((row_ >> 2) & 3u)); \
                __builtin_amdgcn_global_load_lds((const unsigned*)(proj + (rk0_ + row_) * DIN + 2048 + hd * 128 + 8 * ch_), (LAS unsigned*)(vimg0 + (buf_) * 8192u + i_ * 1024u), 16, 0, 0); } \
            { const f32x4 k4_ = *(const f32x4*)(ksq + ((rk0_ + r32) * 8 + 4 + hd) * 4); rkv = 1.f / sqrtf(((k4_[0] + k4_[1]) + (k4_[2] + k4_[3])) * (1.f / 128.f) + EPS); } } while (0)
        ATT_LOAD_TILE(qb, 0u);
#pragma unroll 1
        for (int kt = qb; kt >= 0; --kt) {
            const LAS unsigned char* vimg = vimg0 + vbuf * 8192u;
            asm volatile("s_waitcnt vmcnt(0)" ::: "memory");
            if (lane < 32) rkbuf[lane] = rkv;
            f32x16 z;
#pragma unroll
            for (int q = 0; q < 16; ++q) z[q] = 0.f;
#pragma unroll
            for (int s = 0; s < 8; ++s) z = __builtin_amdgcn_mfma_f32_32x32x16_bf16(kf[s], qf[s], z, 0, 0, 0);
            __builtin_amdgcn_sched_barrier(0);
            if (kt > 0) { ATT_LOAD_TILE(kt - 1, vbuf ^ 1u); }
            __builtin_amdgcn_sched_barrier(0);
            f32x16 Lh;
            const bool diag = (kt == qb);
#pragma unroll
            for (int g = 0; g < 4; ++g) { const f32x4 rk4 = *(const LAS f32x4*)(rkbuf + 8 * g + 4 * hh);
#pragma unroll
                for (int e = 0; e < 4; ++e) { const int q = 4 * g + e; const float z2 = z[q] * rk4[e]; z[q] = z2 + R;
                    const bool valid = !diag || (crow(q, hh) < r32);
                    Lh[q] = valid ? -__builtin_amdgcn_logf(1.f + __builtin_amdgcn_exp2f(z2)) : 0.f; } }
            const float seed0 = z[0];
#pragma unroll
            for (int s = 0; s < 2; ++s) {
                const bf16x8 lhi = pack8(Lh[8 * s], Lh[8 * s + 1], Lh[8 * s + 2], Lh[8 * s + 3], Lh[8 * s + 4], Lh[8 * s + 5], Lh[8 * s + 6], Lh[8 * s + 7]);
                float lo[8];
#pragma unroll
                for (int j = 0; j < 8; ++j) lo[j] = Lh[8 * s + j] - __builtin_bit_cast(float, ((unsigned)(unsigned short)lhi[j]) << 16);
                const bf16x8 llo = pack8(lo[0], lo[1], lo[2], lo[3], lo[4], lo[5], lo[6], lo[7]);
                z = __builtin_amdgcn_mfma_f32_32x32x16_bf16(tf[s], lhi, z, 0, 0, 0);
                z = __builtin_amdgcn_mfma_f32_32x32x16_bf16(tf[s], llo, z, 0, 0, 0);
            }
            const float tot = z[0] - seed0;
#pragma unroll
            for (int q = 0; q < 16; ++q) { const bool valid = !diag || (crow(q, hh) < r32); const float a = __builtin_amdgcn_exp2f(z[q]); z[q] = valid ? a : 0.f; }
            R += __shfl(tot, r32);
#pragma unroll
            for (int s = 0; s < 2; ++s) {
                const bf16x8 pf = pack8(z[8 * s], z[8 * s + 1], z[8 * s + 2], z[8 * s + 3], z[8 * s + 4], z[8 * s + 5], z[8 * s + 6], z[8 * s + 7]);
#pragma unroll
                for (int db = 0; db < 4; ++db) {
                    const unsigned ra = (unsigned)(16 * s + 4 * hh) + tq, rb = ra + 8u;
                    const s16x4 lo4 = vtr(vimg + off_b(ra, 4u * db + 2u * blk16 + (tp >> 1)) + 8u * (tp & 1));
                    const s16x4 hi4 = vtr(vimg + off_b(rb, 4u * db + 2u * blk16 + (tp >> 1)) + 8u * (tp & 1));
                    const bf16x8 vf = __builtin_shufflevector(lo4, hi4, 0, 1, 2, 3, 4, 5, 6, 7);
                    o[db] = __builtin_amdgcn_mfma_f32_32x32x16_bf16(vf, pf, o[db], 0, 0, 0);
                }
            }
            vbuf ^= 1u;
            if (__builtin_amdgcn_ballot_w64(R >= -150.f) == 0ull) break;
        }
#undef ATT_LOAD_TILE
        asm volatile("s_waitcnt vmcnt(0)" ::: "memory");
        float ss = 0.f;
#pragma unroll
        for (int db = 0; db < 4; ++db)
#pragma unroll
            for (int q = 0; q < 16; ++q) ss += o[db][q] * o[db][q];
        ss += __shfl_xor(ss, 32);
        const float rs = 1.f / sqrtf(ss * (1.f / 128.f) + EPS);
        bf16_t* yo = ymix + rowq * DMIX + 512 + hd * 128;
        const float* og = out_norm_g + 512 + hd * 128;
#pragma unroll
        for (int db = 0; db < 4; ++db)
#pragma unroll
            for (int g = 0; g < 4; ++g) { const int d0 = 32 * db + 8 * g + 4 * hh; const f32x4 gg = *(const f32x4*)(og + d0);
                u32x2 w; w.x = pk2(o[db][4 * g] * rs * gg[0], o[db][4 * g + 1] * rs * gg[1]); w.y = pk2(o[db][4 * g + 2] * rs * gg[2], o[db][4 * g + 3] * rs * gg[3]);
                *(u32x2*)(yo + d0) = w; }
    }
}

__device__ __forceinline__ void phase_router(Frame& F, const ArgV A, int l) {
    int vcu_ = F.vcu, gw_ = F.gw; asm volatile("" : "+s"(vcu_), "+s"(gw_)); (void)vcu_; (void)gw_;
    const int tid_ = fresh_tid(), lane = tid_ & 63;
    const float* modv = (const float*)(A.ws() + WS_MODV); bf16_t* hout = (bf16_t*)A.out(); const bf16_t* xb = (const bf16_t*)(A.ws() + WS_XB);
    int* tok = (int*)(A.ws() + WS_TOK); int* list = (int*)(A.ws() + WS_LIST);
    const bf16_t* WrT = (const bf16_t*)(A.ws() + WS_WRT) + (size_t)l * 64 * DM;
    const float *b_group = A.in(16) + l * 4, *b_route = A.in(18) + l * 32;
    volatile LAS unsigned* lcnt = F.MISC + 128;
    for (int blk = vcu_; blk < NT / 128; blk += F.G) {
        const int b = (blk * 128) / SEQ;
        const float* mA_ = modv + ((size_t)(l * NB + b) * 6 + 4) * DM; const float* mS_ = modv + ((size_t)(l * NB + b) * 6 + 3) * DM;
        if (tid_ < 64) lcnt[tid_] = 0u;
#pragma unroll 1
        for (int i = 0; i < 16; i += 2) {
            const int row = blk * 128 + F.wave * 16 + i;
            const float *mA = mA_, *mS = mS_;
            asm volatile("" : "+s"(mA), "+s"(mS));
            const u32x2* xr0 = (const u32x2*)(xb + (size_t)row * DM) + lane; const u32x2* xr1 = xr0 + DM / 4;
            u32x2 w0_[8], w1_[8];
#pragma unroll
            for (int j = 0; j < 8; ++j) { w0_[j] = xr0[64 * j]; w1_[j] = xr1[64 * j]; }
            float ss0 = 0.f, ss1 = 0.f;
#pragma unroll
            for (int j = 0; j < 8; ++j) { const float a0 = bflo(w0_[j].x), a1 = bfhi(w0_[j].x), a2 = bflo(w0_[j].y), a3 = bfhi(w0_[j].y); ss0 += (a0 * a0 + a1 * a1) + (a2 * a2 + a3 * a3);
                const float c0 = bflo(w1_[j].x), c1 = bfhi(w1_[j].x), c2 = bflo(w1_[j].y), c3 = bfhi(w1_[j].y); ss1 += (c0 * c0 + c1 * c1) + (c2 * c2 + c3 * c3); }
#pragma unroll
            for (int o = 1; o < 64; o <<= 1) { ss0 += __shfl_xor(ss0, o); ss1 += __shfl_xor(ss1, o); }
            const float rstd0 = 1.f / sqrtf(ss0 * (1.f / DM) + EPS), rstd1 = 1.f / sqrtf(ss1 * (1.f / DM) + EPS);
            u32x2* ho0 = (u32x2*)(hout + (size_t)row * DM) + lane; u32x2* ho1 = ho0 + DM / 4;
#pragma unroll
            for (int j = 0; j < 8; ++j) { const f32x4 a = *((const f32x4*)mA + lane + 64 * j), sh = *((const f32x4*)mS + lane + 64 * j);
                u32x2 o; o.x = pk2(bflo(w0_[j].x) * rstd0 * a[0] + sh[0], bfhi(w0_[j].x) * rstd0 * a[1] + sh[1]); o.y = pk2(bflo(w0_[j].y) * rstd0 * a[2] + sh[2], bfhi(w0_[j].y) * rstd0 * a[3] + sh[3]); ho0[64 * j] = o;
                u32x2 p; p.x = pk2(bflo(w1_[j].x) * rstd1 * a[0] + sh[0], bfhi(w1_[j].x) * rstd1 * a[1] + sh[1]); p.y = pk2(bflo(w1_[j].y) * rstd1 * a[2] + sh[2], bfhi(w1_[j].y) * rstd1 * a[3] + sh[3]); ho1[64 * j] = p; }
        }
        asm volatile("s_waitcnt vmcnt(0)" ::: "memory");
        __syncthreads();
        int e0 = 0, e1 = 0, lp0 = 0, lp1 = 0; float w0 = 0.f, w1 = 0.f; bool owner = false;
        const int r32 = lane & 31, hh = lane >> 5, kq = F.wave >> 2, wq = F.wave & 3;
        const int myrow = blk * 128 + wq * 32 + r32;
        f32x16 acc0, acc1;
#pragma unroll
        for (int q = 0; q < 16; ++q) { acc0[q] = 0.f; acc1[q] = 0.f; }
        {
            const bf16x8* hb = (const bf16x8*)(hout + (size_t)myrow * DM + 8 * hh + kq * 1024);
            const bf16x8* wa = (const bf16x8*)(WrT + (size_t)r32 * DM + 8 * hh + kq * 1024);
            const bf16x8* wb = (const bf16x8*)(WrT + (size_t)(32 + r32) * DM + 8 * hh + kq * 1024);
#pragma unroll 8
            for (int s = 0; s < 64; ++s) { const bf16x8 bv = hb[2 * s], a0 = wa[2 * s], a1 = wb[2 * s];
                acc0 = __builtin_amdgcn_mfma_f32_32x32x16_bf16(a0, bv, acc0, 0, 0, 0);
                acc1 = __builtin_amdgcn_mfma_f32_32x32x16_bf16(a1, bv, acc1, 0, 0, 0); }
        }
        LAS float* part = (LAS float*)F.lds;
        if (kq == 1) {
#pragma unroll
            for (int q = 0; q < 16; ++q) part[(wq * 20 + q) * 64 + lane] = acc0[q];
#pragma unroll
            for (int q = 0; q < 4; ++q) part[(wq * 20 + 16 + q) * 64 + lane] = acc1[q];
        }
        __syncthreads();
        if (kq == 0) {
#pragma unroll
            for (int q = 0; q < 16; ++q) acc0[q] += part[(wq * 20 + q) * 64 + lane];
#pragma unroll
            for (int q = 0; q < 4; ++q) acc1[q] += part[(wq * 20 + 16 + q) * 64 + lane];
            float gl[4];
#pragma unroll
            for (int q = 0; q < 4; ++q) gl[q] = acc1[q] + b_group[q];
            int gi = 0; float gm = gl[0];
#pragma unroll
            for (int q = 1; q < 4; ++q) if (gl[q] > gm) { gm = gl[q]; gi = q; }
            float den = 0.f;
#pragma unroll
            for (int q = 0; q < 4; ++q) den += __expf(gl[q] - gm);
            const float pg = 1.f / den;
            owner = ((gi >> 1) == hh);
            float ev[8];
#pragma unroll
            for (int q = 0; q < 8; ++q) ev[q] = ((gi & 1) ? acc0[8 + q] : acc0[q]) + b_route[(owner ? gi : 2 * hh) * 8 + q];
            int i0 = 0; float v0 = ev[0];
#pragma unroll
            for (int q = 1; q < 8; ++q) if (ev[q] > v0) { v0 = ev[q]; i0 = q; }
            int i1 = -1; float v1 = -3.0e38f;
#pragma unroll
            for (int q = 0; q < 8; ++q) if (q != i0 && ev[q] > v1) { v1 = ev[q]; i1 = q; }
            const float e1x = __expf(v1 - v0); w0 = pg / (1.f + e1x); w1 = pg * e1x / (1.f + e1x);
            e0 = gi * 8 + i0; e1 = gi * 8 + i1;
            if (owner) { lp0 = (int)__hip_atomic_fetch_add((LAS unsigned*)(lcnt + e0), 1u, __ATOMIC_RELAXED, __HIP_MEMORY_SCOPE_WORKGROUP);
                         lp1 = (int)__hip_atomic_fetch_add((LAS unsigned*)(lcnt + e1), 1u, __ATOMIC_RELAXED, __HIP_MEMORY_SCOPE_WORKGROUP); }
        }
        __syncthreads();
        if (tid_ < 32) { const unsigned n = lcnt[tid_]; unsigned base = 0u; if (n) base = atomicAdd(F.ctl + CW_CNT + (l * 32 + tid_) * 64, n); lcnt[32 + tid_] = base; }
        __syncthreads();
        if (owner) {
            const int p0 = (int)lcnt[32 + e0] + lp0, p1 = (int)lcnt[32 + e1] + lp1;
            list[(size_t)e0 * NT + p0] = myrow; list[(size_t)e1 * NT + p1] = myrow;
            tok[myrow * 8 + 0] = e0; tok[myrow * 8 + 1] = e1; tok[myrow * 8 + 2] = p0; tok[myrow * 8 + 3] = p1;
            tok[myrow * 8 + 4] = __builtin_bit_cast(int, w0); tok[myrow * 8 + 5] = __builtin_bit_cast(int, w1);
        }
        __syncthreads();
    }
}

__global__ void __launch_bounds__(512, 2) fwd_kernel(Args args_unused) {
    extern __shared__ __attribute__((aligned(16))) unsigned char lds_raw[];
    Frame F;
    F.lds = (LAS unsigned char*)lds_raw;
    F.MISC = (volatile LAS unsigned*)(F.lds + MISC_OFF);
    F.tid = threadIdx.x; F.lane = F.tid & 63; F.wave = __builtin_amdgcn_readfirstlane(F.tid >> 6);
    F.G = gridDim.x; { const int bx = blockIdx.x; F.vcu = (F.G % 8 == 0) ? (bx % 8) * (F.G / 8) + bx / 8 : bx; }
    F.gw = F.vcu * 8 + F.wave; F.NGW = F.G * 8;
    { const ArgV a0 = get_args(); F.ctl = (unsigned*)(a0.ws() + WS_CTL); }
    for (int u = F.tid; u < 256; u += 512) F.MISC[u] = 0u;
    __syncthreads();
    int lo, hi; { const ArgV a0 = get_args(); lo = a0.ph_lo(); hi = a0.ph_hi(); }
    XcdBarrier bar; bar.bar = F.ctl + CW_BAR; bar.x = 0; bar.st = nullptr;
    if (hi - lo > 1) bar = xcd_barrier_post(F.ctl + CW_BAR, F.MISC);
#ifndef PH_MASK
#define PH_MASK 0x1ff
#endif
#define PM(j) (((PH_MASK) >> (j)) & 1)
#define IN(k) (lo <= (k) && (k) < hi)
#define SEAM(k) do { if (IN(k) && IN((k) + 1)) xcd_barrier(bar); } while (0)
#define PB(kind) do { if ((kind) == PROBE_KIND && blockIdx.x == 0 && threadIdx.x == 0) { const unsigned long long t_ = __builtin_amdgcn_s_memrealtime(); F.MISC[200] = (unsigned)t_; F.MISC[201] = (unsigned)(t_ >> 32); } } while (0)
#define PE(kind) do { if ((kind) == PROBE_KIND && blockIdx.x == 0 && threadIdx.x == 0) { const unsigned long long t_ = __builtin_amdgcn_s_memrealtime() - (((unsigned long long)F.MISC[201] << 32) | F.MISC[200]); \
        const unsigned long long a_ = (((unsigned long long)F.MISC[203] << 32) | F.MISC[202]) + t_; F.MISC[202] = (unsigned)a_; F.MISC[203] = (unsigned)(a_ >> 32); } } while (0)
    PB(0); if (PM(0) && IN(0)) { const ArgV args = get_args(); phase_modpart(F, args.in(1), args.in(2), (float*)(args.ws() + WS_MODPART)); } SEAM(0); PE(0);
    PB(1); if (PM(0) && IN(1)) { const ArgV args = get_args(); phase_prep(F, args); } SEAM(1); PE(1);
    for (int l = 0; l < NL; ++l) {
        const int pb = 2 + 7 * l;
        PB(2); if (PM(1) && IN(pb + 0)) { const ArgV args = get_args(); if (l == 0) phase_norm1<0>(F, args, l); else phase_norm1<1>(F, args, l); } SEAM(pb + 0); PE(2);
        PB(3); if (PM(2) && IN(pb + 1)) {
            const ArgV args = get_args();
            DenseSched S; S.init(NT, DIN, DM, (const bf16_t*)(args.ws() + WS_WINT) + (size_t)l * DIN * DM, F.G, (int)blockIdx.x);
            EpiProj E{(bf16_t*)(args.ws() + WS_PROJ), (float*)(args.ws() + WS_KSQ)};
            pg8::gemm_phase<EpiProj, DenseSched>(F.lds, (const bf16_t*)args.out(), DM, S, E);
        } SEAM(pb + 1); PE(3);
        PB(4); if (IN(pb + 2)) { PB(10); if (PM(3)) { const ArgV args = get_args(); phase_gmlp(F, args, l); } PE(10); PB(11); if (PM(4)) { const ArgV args = get_args(); phase_attn(F, args, l); } PE(11); } SEAM(pb + 2); PE(4);
        PB(5); if (PM(7) && IN(pb + 3)) {
            const ArgV args = get_args();
            DenseSched S; S.init(NT, DM, DMIX, (const bf16_t*)(args.ws() + WS_WOUTT) + (size_t)l * DM * DMIX, F.G, (int)blockIdx.x);
            EpiOut E{(bf16_t*)(args.ws() + WS_XB), (const float*)(args.ws() + WS_MODV) + ((size_t)(l * NB) * 6 + 2) * DM};
            pg8::gemm_phase<EpiOut, DenseSched>(F.lds, (const bf16_t*)(args.ws() + WS_YMIX), DMIX, S, E);
        } SEAM(pb + 3); PE(5);
        PB(6); if (PM(5) && IN(pb + 4)) { const ArgV args = get_args(); phase_router(F, args, l); } SEAM(pb + 4); PE(6);
        PB(7); if (PM(6) && IN(pb + 5)) {
            const ArgV args = get_args();
            build_tiles(F, l);
            MoeSched<true> S; S.tp = F.MISC + 16; S.cnt = F.MISC + 64; S.te = (const volatile LAS unsigned*)(F.lds + TILE_E_OFF); S.list = (const int*)(args.ws() + WS_LIST);
            S.Bt = (const bf16_t*)(args.ws() + WS_WGUT) + (size_t)l * NE * 512 * DM; S.bstride_e = (size_t)512 * DM; S.K = DM; S.npn = 2; S.lognpn = 1; S.G = F.G; S.c = F.vcu;
            EpiAct E{(bf16_t*)(args.ws() + WS_ACT)};
            pg8::gemm_phase<EpiAct, MoeSched<true> >(F.lds, (const bf16_t*)args.out(), DM, S, E);
        } SEAM(pb + 5); PE(7);
        PB(8); if (PM(8) && IN(pb + 6)) {
            const ArgV args = get_args();
            build_tiles(F, l);
            MoeSched<false> S; S.tp = F.MISC + 16; S.cnt = F.MISC + 64; S.te = (const volatile LAS unsigned*)(F.lds + TILE_E_OFF); S.list = nullptr;
            S.Bt = (const bf16_t*)(args.ws() + WS_WDT) + (size_t)l * NE * DM * DE; S.bstride_e = (size_t)DM * DE; S.K = DE; S.npn = 8; S.lognpn = 3; S.G = F.G; S.c = F.vcu;
            EpiY E{(unsigned char*)(args.ws() + WS_YSLOT)};
            pg8::gemm_phase<EpiY, MoeSched<false> >(F.lds, (const bf16_t*)(args.ws() + WS_ACT), DE, S, E);
        } SEAM(pb + 6); PE(8);
    }
    PB(9); if (PM(1) && IN(30)) { const ArgV args = get_args(); phase_norm1<2>(F, args, NL); } PE(9);
    if (PROBE_KIND >= 0 && blockIdx.x == 0 && threadIdx.x == 0) { const unsigned long long pacc = (((unsigned long long)F.MISC[203] << 32) | F.MISC[202]);
        const unsigned long long t0 = __builtin_amdgcn_s_memrealtime(); while (__builtin_amdgcn_s_memrealtime() - t0 < 4ull * pacc) __builtin_amdgcn_s_sleep(20); }
#undef IN
#undef SEAM
}

extern "C" void kernel_launch(void* const* d_in, const int* in_sizes, int n_in, void* d_out, int out_size, void* d_ws, size_t ws_size, hipStream_t stream) {
    static int grid = 0;
    if (grid == 0) {
        if (n_in != 22 || out_size != NT * DM || ws_size < WS_END) { fprintf(stderr, "kernel_launch: unexpected problem (n_in %d out %d ws %zu)\n", n_in, out_size, ws_size); grid = -1; return; }
        int dev = 0, cus = 0;
        if (hipGetDevice(&dev) != hipSuccess || hipDeviceGetAttribute(&cus, hipDeviceAttributeMultiprocessorCount, dev) != hipSuccess) { grid = -1; return; }
        if (hipFuncSetAttribute((const void*)fwd_kernel, hipFuncAttributeMaxDynamicSharedMemorySize, LDS_BYTES) != hipSuccess) { fprintf(stderr, "kernel_launch: hipFuncSetAttribute failed\n"); grid = -1; return; }
        int per_cu = 0;
        (void)hipOccupancyMaxActiveBlocksPerMultiprocessor(&per_cu, (const void*)fwd_kernel, 512, LDS_BYTES);
        (void)hipGetLastError();
        grid = cus;
    }
    if (grid < 0) return;
    (void)hipMemsetAsync((char*)d_ws + WS_CTL, 0, CTL_ZERO_BYTES, stream);
    Args a{};
    for (int i = 0; i < 22; ++i) a.in[i] = (const float*)d_in[i];
    a.out = (float*)d_out; a.ws = (unsigned char*)d_ws;
#if MK_ONE_LAUNCH
    a.ph_lo = 0; a.ph_hi = NPHASE;
    hipLaunchKernelGGL(fwd_kernel, dim3(grid), dim3(512), LDS_BYTES, stream, a);
#else
    for (int p = 0; p < NPHASE; ++p) { a.ph_lo = p; a.ph_hi = p + 1; hipLaunchKernelGGL(fwd_kernel, dim3(grid), dim3(512), LDS_BYTES, stream, a); }
#endif
}
```

```cpp
#include <hip/hip_runtime.h>
#include <cstdio>
#include <cstdint>

#ifndef PROBE_KIND
#define PROBE_KIND -1
#endif
#ifndef PROBE_BLOCK
#define PROBE_BLOCK 0
#endif
#ifndef MK_ONE_LAUNCH
#define MK_ONE_LAUNCH 1
#endif

#define LAS __attribute__((address_space(3)))
#define GAS __attribute__((address_space(1)))
typedef unsigned short bf16_t;
typedef short bf16x8 __attribute__((ext_vector_type(8)));
typedef float f32x4 __attribute__((ext_vector_type(4)));
typedef float f32x2 __attribute__((ext_vector_type(2)));
typedef float f32x16 __attribute__((ext_vector_type(16)));
typedef unsigned u32x4 __attribute__((ext_vector_type(4)));
typedef unsigned u32x2 __attribute__((ext_vector_type(2)));
typedef __bf16 bf16x2_t __attribute__((ext_vector_type(2)));

constexpr int DM = 2048, NB = 4, SEQ = 8192, NL = 4, NT = NB * SEQ;
constexpr int DIN = 2560, DMIX = 1024, NE = 32, DE = 256, NMOD = 6 * DM;
constexpr int SLOT_TILES = NT * 2 / 256 + NE, NSLOT = SLOT_TILES * 256;
constexpr float EPS = 1e-6f;
constexpr int NPHASE = 31;

constexpr size_t MiB = 1u << 20;
constexpr size_t WS_CTL = 0, CTL_ZERO_BYTES = 1 * MiB;
constexpr size_t WS_MODPART = 1 * MiB;
constexpr size_t WS_MODV = 2 * MiB;
constexpr size_t WS_TOK = 3 * MiB;
constexpr size_t WS_LIST = 4 * MiB;
constexpr size_t WS_KSQ = 8 * MiB;
constexpr size_t WS_WINT = 12 * MiB;
constexpr size_t WS_WOUTT = 52 * MiB;
constexpr size_t WS_WGUT = 68 * MiB;
constexpr size_t WS_WDT = 324 * MiB;
constexpr size_t WS_XB = 452 * MiB;
constexpr size_t WS_PROJ = 580 * MiB;
constexpr size_t WS_YMIX = 740 * MiB;
constexpr size_t WS_ACT = 804 * MiB;
constexpr size_t WS_YSLOT = 840 * MiB;
constexpr size_t WS_WRT = 1128 * MiB;
constexpr size_t WS_WGM = 1129 * MiB;
constexpr size_t WS_END = 1130 * MiB;
static_assert(WS_ACT + (size_t)NSLOT * 256 * 2 <= WS_YSLOT && WS_YSLOT + (size_t)NSLOT * 2048 * 2 <= WS_WRT, "ws map");
constexpr int CW_BAR = 4096;
constexpr int CW_CNT = 16384;

constexpr int LDS_BYTES = 147456;
constexpr int TILE_E_OFF = 131072;
constexpr int OFFN_OFF = 133120;
constexpr int MISC_OFF = 147456 - 1024;

#define RLX_AGENT __ATOMIC_RELAXED, __HIP_MEMORY_SCOPE_AGENT
__device__ __forceinline__ unsigned f2bf(float f) { unsigned u = __builtin_bit_cast(unsigned, f); return (u + 0x7fffu + ((u >> 16) & 1u)) >> 16; }
__device__ __forceinline__ unsigned pk2(float lo, float hi) { f32x2 v = {lo, hi}; bf16x2_t b = __builtin_convertvector(v, bf16x2_t); return __builtin_bit_cast(unsigned, b); }
__device__ __forceinline__ float bflo(unsigned u) { return __builtin_bit_cast(float, u << 16); }
__device__ __forceinline__ float bfhi(unsigned u) { return __builtin_bit_cast(float, u & 0xffff0000u); }
__device__ __forceinline__ float wave_sum(float v) {
#pragma unroll
    for (int o = 1; o < 64; o <<= 1) v += __shfl_xor(v, o);
    return v;
}
__device__ __forceinline__ int fresh_tid() { int t = threadIdx.x; asm volatile("" : "+v"(t)); return t; }
__device__ __forceinline__ float gelu_exact(float x) { return 0.5f * x * (1.f + erff(x * 0.70710678118654752f)); }
__device__ __forceinline__ float silu_f(float x) { return x / (1.f + __expf(-x)); }

#define XB_TMO      128
#define XB_XCNT(j)  (256  + 64 * (j))
#define XB_XSUB(j)  (1280 + 64 * (j))
#define XB_XGEN(j)  (2304 + 64 * (j))
#define XB_TOP      3328
#define XB_TOPGEN   3392
#define XCD_BAR_WORDS 3456
#define XB_SPIN_CAP (1u << 22)
__device__ __forceinline__ unsigned xb_ld(unsigned* p)              { return __hip_atomic_load(p, __ATOMIC_RELAXED, __HIP_MEMORY_SCOPE_AGENT); }
__device__ __forceinline__ unsigned xb_add(unsigned* p, unsigned v) { return __hip_atomic_fetch_add(p, v, __ATOMIC_RELAXED, __HIP_MEMORY_SCOPE_AGENT); }
__device__ __forceinline__ unsigned xb_xcc_id() { return (unsigned)__builtin_amdgcn_s_getreg((3 << 11) | 20) & 0xFu; }
#define XB_SPIN(cond, bar) do { unsigned _sp = 0; while (cond) { __builtin_amdgcn_s_sleep(1); \
    if ((++_sp & 255u) == 0u) { if (xb_ld(&(bar)[XB_TMO])) break; if (_sp > XB_SPIN_CAP) { atomicAdd(&(bar)[XB_TMO], 1u); break; } } } } while (0)
struct XcdBarrier { unsigned* bar; unsigned x; volatile LAS unsigned* st; };
__device__ __forceinline__ XcdBarrier xcd_barrier_post(unsigned* bar, volatile LAS unsigned* st) {
    XcdBarrier b; b.bar = bar; b.x = xb_xcc_id(); b.st = st;
    if (threadIdx.x == 0) (void)xb_add(&bar[XB_XCNT(b.x)], 1u);
    return b;
}
__device__ __forceinline__ void xcd_barrier_complete(unsigned* bar, unsigned x, unsigned& nloc, unsigned& nx) {
    const unsigned G = gridDim.x * gridDim.y * gridDim.z;
    unsigned sum, cnt, mine, sp = 0u;
    for (;;) {
        sum = 0u; cnt = 0u; mine = 0u;
#pragma unroll
        for (unsigned j = 0; j < 16; ++j) { const unsigned c = xb_ld(&bar[XB_XCNT(j)]); sum += c; cnt += (c > 0u) ? 1u : 0u; mine = (j == x) ? c : mine; }
        if (sum == G) break;
        __builtin_amdgcn_s_sleep(1);
        if ((++sp & 255u) == 0u) { if (xb_ld(&bar[XB_TMO])) break; if (sp > XB_SPIN_CAP) { atomicAdd(&bar[XB_TMO], 1u); break; } }
    }
    nloc = mine > 0u ? mine : 1u; nx = cnt > 0u ? cnt : 1u;
}
__device__ __forceinline__ void xcd_barrier(const XcdBarrier& b) {
    asm volatile("s_waitcnt vmcnt(0)" ::: "memory");
    __syncthreads();
    if (threadIdx.x == 0) {
        unsigned* bar = b.bar; unsigned bx = b.x;
        asm volatile("" : "+s"(bar), "+s"(bx));
        __builtin_amdgcn_s_waitcnt(0);
        unsigned nloc = b.st[0], nx = b.st[1];
        if (nloc == 0u) { xcd_barrier_complete(bar, bx, nloc, nx); b.st[0] = nloc; b.st[1] = nx; }
        const unsigned old = xb_add(&bar[XB_XSUB(bx)], 1u);
        const unsigned gen = old / nloc;
        if (old + 1u == (gen + 1u) * nloc) {
            __builtin_amdgcn_fence(__ATOMIC_RELEASE, "agent");
            asm volatile("s_waitcnt vmcnt(0)" ::: "memory");
            const unsigned og = xb_add(&bar[XB_TOP], 1u);
            const unsigned tg = og / nx;
            if (og + 1u == (tg + 1u) * nx) xb_add(&bar[XB_TOPGEN], 1u);
            else XB_SPIN(xb_ld(&bar[XB_TOPGEN]) == tg, bar);
            __builtin_amdgcn_fence(__ATOMIC_ACQUIRE, "agent");
            xb_add(&bar[XB_XGEN(bx)], 1u);
            asm volatile("s_waitcnt vmcnt(0)" ::: "memory");
        } else {
            XB_SPIN(xb_ld(&bar[XB_XGEN(bx)]) == gen, bar);
            __builtin_amdgcn_fence(__ATOMIC_ACQUIRE, "agent");
            asm volatile("s_waitcnt vmcnt(0)" ::: "memory");
        }
    }
    __syncthreads();
}

namespace pg8 {
constexpr int BM = 256, BK = 64, HALF = 128, HTB = HALF * BK * 2, NXCD = 8, WGM = 8;
__device__ __forceinline__ int lds_byte(int r, int c) { const int st = (r >> 4) * 2 + (c >> 5), rr = r & 15, cc = c & 31, ob = rr * 64 + cc * 2; return st * 1024 + (ob ^ (((ob >> 9) & 1) << 5)); }
__device__ __forceinline__ void stage_rc(int b, int& R, int& C) { const int st = b / 1024, sb = b % 1024, swz = sb ^ (((sb >> 9) & 1) << 5); R = (st >> 1) * 16 + swz / 64; C = (st & 1) * 32 + (swz % 64) / 2; }
__device__ __forceinline__ int perm32(int rho) { const int n = rho >> 4, i = rho & 15; return 8 * (i >> 2) + 4 * n + (i & 3); }

template <class Epi, class Sched>
__device__ __forceinline__ void gemm_phase(LAS unsigned char* lds, const bf16_t* Abase, const int K, const Sched& S, const Epi& E) {
    typedef typename Sched::Unit Unit;
    constexpr bool GATHER = Sched::GATHER;
    const int tid = fresh_tid(), wid = __builtin_amdgcn_readfirstlane(tid >> 6), lane = tid & 63, wr = wid >> 2, wc = wid & 3, fr = lane & 15, fq = lane >> 4;
    const int nt = K / BK;
    unsigned voffA[2], voffB[2];
#pragma unroll
    for (int i = 0; i < 2; ++i) { int R, C; stage_rc(tid * 16 + i * 8192, R, C); const int Rb = Epi::PERM ? ((R & ~31) + perm32(R & 31)) : R;
        voffA[i] = (unsigned)(R * K + C) * 2u; voffB[i] = (unsigned)(Rb * K + C) * 2u; }
    const size_t kstep = (size_t)(BK * 2);
    const size_t hstep = (size_t)HALF * K * 2;
    const unsigned ldsw0 = (unsigned)wid * 1024u; unsigned ldsw = ldsw0;
    const int aoff = lds_byte(wr * 64 + fr, fq * 8), boff = lds_byte(wc * 32 + fr, fq * 8);
    const char* Ab = (const char*)Abase;
#define PG8_SA(b, h) (((b) * 2 + (h)) * HTB)
#define PG8_SB(b, h) ((4 + (b) * 2 + (h)) * HTB)
#define PG8_STAGE(bufoff, gbase, voff) do { _Pragma("unroll") for (int _i = 0; _i < 2; ++_i) \
        __builtin_amdgcn_global_load_lds((const unsigned*)((const char*)(gbase) + (voff)[_i]), (LAS unsigned*)(lds + (bufoff) + ldsw + _i * 8192), 16, 0, 0); } while (0)
#define PG8_STAGEA(bufoff, p, kb, off, h) do { if constexpr (GATHER) { PG8_STAGE(bufoff, Ab + (kb), (off) + 2 * (h)); } else { PG8_STAGE(bufoff, (p) + (h) * hstep, voffA); } } while (0)
#define PG8_LDA(dst, b, h) do { _Pragma("unroll") for (int m = 0; m < 4; ++m) _Pragma("unroll") for (int k = 0; k < 2; ++k) dst[m][k] = *(const LAS bf16x8*)(lds + PG8_SA(b, h) + aoff + m * 2048 + k * 1024); } while (0)
#define PG8_LDB(dst, b, h) do { _Pragma("unroll") for (int n = 0; n < 2; ++n) _Pragma("unroll") for (int k = 0; k < 2; ++k) dst[n][k] = *(const LAS bf16x8*)(lds + PG8_SB(b, h) + boff + n * 2048 + k * 1024); } while (0)
#define PG8_MMA(ai, bj, At, Bt) do { __builtin_amdgcn_s_setprio(1); _Pragma("unroll") for (int m = 0; m < 4; ++m) _Pragma("unroll") for (int n = 0; n < 2; ++n) _Pragma("unroll") for (int k = 0; k < 2; ++k) \
        acc[ai][bj][m][n] = __builtin_amdgcn_mfma_f32_16x16x32_bf16(Bt[n][k], At[m][k], acc[ai][bj][m][n], 0, 0, 0); __builtin_amdgcn_s_setprio(0); } while (0)
#define PG8_WAIT_V(n) asm volatile("s_waitcnt vmcnt(" #n ")" ::: "memory")
#define PG8_WAIT_L(n) asm volatile("s_waitcnt lgkmcnt(" #n ")" ::: "memory")
#define PG8_BAR __builtin_amdgcn_s_barrier()
#define PG8_SCHED __builtin_amdgcn_sched_barrier(0)
#define PG8_AOFF(u, dst) do { _Pragma("unroll") for (int _h = 0; _h < 2; ++_h) _Pragma("unroll") for (int _i = 0; _i < 2; ++_i) { \
        int _R, _C; stage_rc(tid * 16 + _i * 8192, _R, _C); dst[_h * 2 + _i] = (S.arow(u, _h * HALF + _R) * (unsigned)K + (unsigned)_C) * 2u; } } while (0)
    Unit cur, nxt; int ui = 0;
    if (!S.next(0, cur)) return;
    f32x4 acc[2][2][4][2];
#pragma unroll
    for (int a = 0; a < 2; ++a)
#pragma unroll
        for (int b = 0; b < 2; ++b)
#pragma unroll
            for (int m = 0; m < 4; ++m)
#pragma unroll
                for (int n = 0; n < 2; ++n) acc[a][b][m][n] = (f32x4){0.f, 0.f, 0.f, 0.f};
    bf16x8 At[4][2], B0[2][2], B1[2][2];
    unsigned offc[4] = {0u, 0u, 0u, 0u}, offn[4] = {0u, 0u, 0u, 0u};
    volatile LAS unsigned* onx = (volatile LAS unsigned*)(lds + OFFN_OFF) + tid * 4;
    if constexpr (GATHER) PG8_AOFF(cur, offc);
    const char* cA = GATHER ? Ab : S.aptr(cur, Ab);
    const char* cB = S.bptr(cur);
    PG8_STAGE(PG8_SB(0, 0), cB, voffB); PG8_STAGE(PG8_SB(0, 1), cB + hstep, voffB); PG8_STAGEA(PG8_SA(0, 0), cA, 0, offc, 0); PG8_STAGEA(PG8_SA(0, 1), cA, 0, offc, 1);
    if (wr == 1) PG8_BAR;
    PG8_WAIT_V(2); PG8_BAR;
    PG8_STAGE(PG8_SB(1, 0), cB + kstep, voffB); PG8_STAGEA(PG8_SA(1, 0), cA + kstep, kstep, offc, 0); PG8_STAGE(PG8_SB(1, 1), cB + hstep + kstep, voffB);
    PG8_WAIT_V(6); PG8_BAR;
    for (;;) {
        const bool has_next = S.next(ui + 1, nxt);
        const char* nA = cA; const char* nB = cB;
        if (has_next) { nB = S.bptr(nxt); if constexpr (!GATHER) nA = S.aptr(nxt, Ab);
            if constexpr (GATHER) { unsigned tmp[4]; PG8_AOFF(nxt, tmp);
#pragma unroll
                for (int j = 0; j < 4; ++j) onx[j] = tmp[j]; } }
#pragma unroll 1
        for (int t = 0; t < nt; t += 2) {
            const bool last = (t == nt - 2);
            unsigned ldsw = ldsw0; asm volatile("" : "+s"(ldsw));
            const char* a1 = cA + (size_t)(t + 1) * kstep; const size_t k1 = (size_t)(t + 1) * kstep;
            const char* a2 = last ? nA : cA + (size_t)(t + 2) * kstep; const size_t k2 = last ? 0 : (size_t)(t + 2) * kstep;
            const char* b2 = last ? nB : cB + (size_t)(t + 2) * kstep;
            const char* a3 = a2 + kstep; const char* b3 = b2 + kstep; const size_t k3 = k2 + kstep;
            if constexpr (GATHER) {
#pragma unroll
                for (int j = 0; j < 4; ++j) offn[j] = offc[j];
                if (last && has_next) {
#pragma unroll
                    for (int j = 0; j < 4; ++j) offn[j] = onx[j];
                }
            }
            PG8_LDB(B0, 0, 0); PG8_LDB(B1, 0, 1); PG8_SCHED; PG8_LDA(At, 0, 0); PG8_STAGEA(PG8_SA(1, 1), a1, k1, offc, 1);
            PG8_WAIT_V(8); PG8_WAIT_L(0); PG8_BAR; PG8_MMA(0, 0, At, B0); PG8_MMA(0, 1, At, B1); PG8_BAR; PG8_SCHED;
            PG8_LDA(At, 0, 1); PG8_STAGE(PG8_SB(0, 0), b2, voffB); PG8_STAGE(PG8_SB(0, 1), b2 + hstep, voffB); PG8_STAGEA(PG8_SA(0, 0), a2, k2, offn, 0);
            PG8_WAIT_V(8); PG8_WAIT_L(0); PG8_BAR; PG8_MMA(1, 0, At, B0); PG8_MMA(1, 1, At, B1); PG8_BAR; PG8_SCHED;
            PG8_LDB(B0, 1, 0); PG8_LDB(B1, 1, 1); PG8_SCHED; PG8_LDA(At, 1, 0); PG8_STAGEA(PG8_SA(0, 1), a2, k2, offn, 1);
            PG8_WAIT_V(8); PG8_WAIT_L(0); PG8_BAR; PG8_MMA(0, 0, At, B0); PG8_MMA(0, 1, At, B1); PG8_BAR; PG8_SCHED;
            PG8_LDA(At, 1, 1); PG8_STAGE(PG8_SB(1, 0), b3, voffB); PG8_STAGE(PG8_SB(1, 1), b3 + hstep, voffB); PG8_STAGEA(PG8_SA(1, 0), a3, k3, offn, 0);
            PG8_WAIT_V(8); PG8_WAIT_L(0); PG8_BAR; PG8_MMA(1, 0, At, B0); PG8_MMA(1, 1, At, B1); PG8_BAR; PG8_SCHED;
        }
        if (wr == 0) PG8_BAR;
        E(acc, cur, wr, wc, fr, fq);
        if (!has_next) break;
#pragma unroll
        for (int a = 0; a < 2; ++a)
#pragma unroll
            for (int b = 0; b < 2; ++b)
#pragma unroll
                for (int m = 0; m < 4; ++m)
#pragma unroll
                    for (int n = 0; n < 2; ++n) acc[a][b][m][n] = (f32x4){0.f, 0.f, 0.f, 0.f};
        cur = nxt; cA = nA; cB = nB; ++ui;
        if constexpr (GATHER) {
#pragma unroll
            for (int j = 0; j < 4; ++j) offc[j] = onx[j];
        }
        if (wr == 1) PG8_BAR;
    }
    PG8_WAIT_V(0);
    PG8_BAR;
#undef PG8_SA
#undef PG8_SB
#undef PG8_STAGE
#undef PG8_STAGEA
#undef PG8_LDA
#undef PG8_LDB
#undef PG8_MMA
#undef PG8_WAIT_V
#undef PG8_WAIT_L
#undef PG8_BAR
#undef PG8_SCHED
#undef PG8_AOFF
}
}

struct DenseUnit { int pm, pn; };
struct DenseSched {
    typedef DenseUnit Unit;
    int nM, nN, nwg, G, c; const bf16_t* Bt; int K;
    __device__ __forceinline__ void init(int M, int N, int K_, const bf16_t* Bt_, int G_, int c_) { nM = M / 256; nN = N / 256; nwg = nM * nN; G = G_; c = c_; Bt = Bt_; K = K_; }
    __device__ __forceinline__ bool next(int i, Unit& u) const {
        const long L = (long)i * G + c; if (L >= nwg) return false;
        int wgid = (int)L; { const int q = nwg / 8, r = nwg % 8, xcd = wgid % 8, off = wgid / 8; wgid = (xcd < r ? xcd * (q + 1) : r * (q + 1) + (xcd - r) * q) + off; }
        const int nig = 8 * nN, gid = wgid / nig, fm = gid * 8, gsz = (nM - fm) < 8 ? (nM - fm) : 8;
        u.pm = fm + ((wgid % nig) % gsz); u.pn = (wgid % nig) / gsz; return true;
    }
    static constexpr bool GATHER = false;
    __device__ __forceinline__ unsigned arow(const Unit& u, int r) const { return (unsigned)(u.pm * 256 + r); }
    __device__ __forceinline__ const char* aptr(const Unit& u, const char* Ab) const { return Ab + (size_t)u.pm * 256 * K * 2; }
    __device__ __forceinline__ const char* bptr(const Unit& u) const { return (const char*)(Bt + (size_t)u.pn * 256 * K); }
};
struct MoeUnit { int e, tile, rt, pn, cnt; };
template <bool GATHER_>
struct MoeSched {
    typedef MoeUnit Unit;
    static constexpr bool GATHER = GATHER_;
    const volatile LAS unsigned* tp;
    const volatile LAS unsigned* cnt;
    const volatile LAS unsigned* te;
    const int* list;
    const bf16_t* Bt; size_t bstride_e; int K; int npn, lognpn; int G, c;
    __device__ __forceinline__ bool next(int i, Unit& u) const {
        const int L = i * G + c; const int tile = L >> lognpn; const int ntile = __builtin_amdgcn_readfirstlane((int)tp[32]);
        if (tile >= ntile) return false;
        u.e = __builtin_amdgcn_readfirstlane((int)te[tile]); u.tile = tile; u.rt = tile - __builtin_amdgcn_readfirstlane((int)tp[u.e]);
        u.cnt = __builtin_amdgcn_readfirstlane((int)cnt[u.e]); u.pn = L & (npn - 1); return true;
    }
    __device__ __forceinline__ const char* aptr(const Unit& u, const char* Ab) const { return Ab + (size_t)u.tile * 256 * K * 2; }
    __device__ __forceinline__ unsigned arow(const Unit& u, int r) const {
        const int slot = u.rt * 256 + r;
        return (slot < u.cnt) ? (unsigned)list[(size_t)u.e * NT + slot] : 0u;
    }
    __device__ __forceinline__ const char* bptr(const Unit& u) const { return (const char*)(Bt + (size_t)u.e * bstride_e + (size_t)u.pn * 256 * K); }
};

struct EpiProj {
    static constexpr bool PERM = true;
    bf16_t* O; float* ksq;
    __device__ __forceinline__ void operator()(const f32x4 (&acc)[2][2][4][2], const DenseUnit& u, int wr, int wc, int fr, int fq) const {
        const int row0 = u.pm * 256 + wr * 64 + fr, col0 = u.pn * 256 + wc * 32 + 8 * fq;
        const bool qk = (u.pn >= 4 && u.pn < 8);
#pragma unroll
        for (int ai = 0; ai < 2; ++ai)
#pragma unroll
            for (int m = 0; m < 4; ++m) { const int row = row0 + ai * 128 + m * 16; bf16_t* rowp = O + (size_t)row * DIN + col0;
#pragma unroll
                for (int bj = 0; bj < 2; ++bj) { const f32x4 v0 = acc[ai][bj][m][0], v1 = acc[ai][bj][m][1];
                    u32x4 w; w.x = pk2(v0[0], v0[1]); w.y = pk2(v0[2], v0[3]); w.z = pk2(v1[0], v1[1]); w.w = pk2(v1[2], v1[3]);
                    *(u32x4*)(rowp + bj * 128) = w;
                    if (qk) { float ss = (v0[0] * v0[0] + v0[1] * v0[1]) + (v0[2] * v0[2] + v0[3] * v0[3]) + (v1[0] * v1[0] + v1[1] * v1[1]) + (v1[2] * v1[2] + v1[3] * v1[3]);
                        ss += __shfl_xor(ss, 16); ss += __shfl_xor(ss, 32);
                        if (fq == 0) ksq[((size_t)row * 8 + (u.pn - 4) * 2 + bj) * 4 + wc] = ss; } } }
    }
};
struct EpiOut {
    static constexpr bool PERM = true;
    bf16_t* X; const float* gate;
    __device__ __forceinline__ void operator()(const f32x4 (&acc)[2][2][4][2], const DenseUnit& u, int wr, int wc, int fr, int fq) const {
        const int row0 = u.pm * 256 + wr * 64 + fr, col0 = u.pn * 256 + wc * 32 + 8 * fq;
        const int b = (u.pm * 256) / SEQ;
        f32x4 gv[2][2];
#pragma unroll
        for (int bj = 0; bj < 2; ++bj)
#pragma unroll
            for (int n = 0; n < 2; ++n) gv[bj][n] = *(const f32x4*)(gate + (size_t)b * 6 * DM + col0 + bj * 128 + n * 4);
#pragma unroll
        for (int ai = 0; ai < 2; ++ai)
#pragma unroll
            for (int m = 0; m < 4; ++m) { bf16_t* rowp = X + (size_t)(row0 + ai * 128 + m * 16) * DM + col0;
#pragma unroll
                for (int bj = 0; bj < 2; ++bj) { u32x4* p = (u32x4*)(rowp + bj * 128); const u32x4 w = *p;
                    const f32x4 a0 = gv[bj][0] * acc[ai][bj][m][0], a1 = gv[bj][1] * acc[ai][bj][m][1];
                    u32x4 o; o.x = pk2(bflo(w.x) + a0[0], bfhi(w.x) + a0[1]); o.y = pk2(bflo(w.y) + a0[2], bfhi(w.y) + a0[3]);
                    o.z = pk2(bflo(w.z) + a1[0], bfhi(w.z) + a1[1]); o.w = pk2(bflo(w.w) + a1[2], bfhi(w.w) + a1[3]); *p = o; }
                asm volatile("" ::: "memory"); }
    }
};
struct EpiAct {
    static constexpr bool PERM = true;
    bf16_t* O;
    __device__ __forceinline__ void operator()(const f32x4 (&acc)[2][2][4][2], const MoeUnit& u, int wr, int wc, int fr, int fq) const {
        const int row0 = u.tile * 256 + wr * 64 + fr, col0 = u.pn * 128 + wc * 32 + 8 * fq;
#pragma unroll
        for (int ai = 0; ai < 2; ++ai)
#pragma unroll
            for (int m = 0; m < 4; ++m) { bf16_t* rowp = O + (size_t)(row0 + ai * 128 + m * 16) * DE + col0;
                float r[8];
#pragma unroll
                for (int n = 0; n < 2; ++n)
#pragma unroll
                    for (int j = 0; j < 4; ++j) r[n * 4 + j] = silu_f(acc[ai][0][m][n][j]) * acc[ai][1][m][n][j];
                u32x4 w; w.x = pk2(r[0], r[1]); w.y = pk2(r[2], r[3]); w.z = pk2(r[4], r[5]); w.w = pk2(r[6], r[7]);
                *(u32x4*)rowp = w; }
    }
};
__device__ __forceinline__ unsigned pk4_fp8(float a, float b, float c, float d) {
    a = __builtin_fminf(__builtin_fmaxf(a, -448.f), 448.f); b = __builtin_fminf(__builtin_fmaxf(b, -448.f), 448.f);
    c = __builtin_fminf(__builtin_fmaxf(c, -448.f), 448.f); d = __builtin_fminf(__builtin_fmaxf(d, -448.f), 448.f);
    int p = 0; p = __builtin_amdgcn_cvt_pk_fp8_f32(a, b, p, false); p = __builtin_amdgcn_cvt_pk_fp8_f32(c, d, p, true); return (unsigned)p; }
struct EpiY {
    static constexpr bool PERM = true;
    unsigned char* O;
    __device__ __forceinline__ void operator()(const f32x4 (&acc)[2][2][4][2], const MoeUnit& u, int wr, int wc, int fr, int fq) const {
        const int row0 = u.tile * 256 + wr * 64 + fr, col0 = u.pn * 256 + wc * 32 + 8 * fq;
#pragma unroll
        for (int ai = 0; ai < 2; ++ai)
#pragma unroll
            for (int m = 0; m < 4; ++m) { unsigned char* rowp = O + (size_t)(row0 + ai * 128 + m * 16) * DM + col0;
#pragma unroll
                for (int bj = 0; bj < 2; ++bj) { const f32x4 v0 = acc[ai][bj][m][0], v1 = acc[ai][bj][m][1];
                    u32x2 w; w.x = pk4_fp8(v0[0], v0[1], v0[2], v0[3]); w.y = pk4_fp8(v1[0], v1[1], v1[2], v1[3]);
                    *(u32x2*)(rowp + bj * 128) = w; } }
    }
};

struct Args { const float* in[22]; float* out; unsigned char* ws; int ph_lo, ph_hi; };
struct Frame {
    LAS unsigned char* lds; volatile LAS unsigned* MISC; unsigned* ctl;
    int tid, lane, wave, vcu, G, gw, NGW;
};

typedef const __attribute__((address_space(4))) Args CArgs;
struct ArgV { CArgs* p;
    __device__ __forceinline__ const float* in(int i) const { return p->in[i]; }
    __device__ __forceinline__ unsigned char* ws() const { return p->ws; }
    __device__ __forceinline__ float* out() const { return p->out; }
    __device__ __forceinline__ int ph_lo() const { return p->ph_lo; }
    __device__ __forceinline__ int ph_hi() const { return p->ph_hi; } };
__device__ __forceinline__ ArgV get_args() { CArgs* p = (CArgs*)__builtin_amdgcn_kernarg_segment_ptr(); asm volatile("" : "+s"(p)); ArgV a; a.p = p; return a; }
__device__ __forceinline__ void transpose_item(const float* src, int N, int k0, int n0, bf16_t* dst, int Kd, int drow0, LAS float* scr, int lane) {
#pragma unroll 4
    for (int i = 0; i < 16; ++i) { const int kk = 4 * i + (lane >> 4), c4 = (lane & 15) * 4;
        const f32x4 v = *(const f32x4*)(src + (size_t)(k0 + kk) * N + n0 + c4);
        LAS float* s = scr + kk * 65 + c4; s[0] = v[0]; s[1] = v[1]; s[2] = v[2]; s[3] = v[3]; }
    asm volatile("s_waitcnt lgkmcnt(0)" ::: "memory");
#pragma unroll 2
    for (int i = 0; i < 8; ++i) { const int cid = lane + 64 * i, n = cid >> 3, c = cid & 7; const LAS float* s = scr + (8 * c) * 65 + n;
        u32x4 o; o.x = pk2(s[0 * 65], s[1 * 65]); o.y = pk2(s[2 * 65], s[3 * 65]); o.z = pk2(s[4 * 65], s[5 * 65]); o.w = pk2(s[6 * 65], s[7 * 65]);
        *(u32x4*)(dst + (size_t)(drow0 + n) * Kd + k0 + 8 * c) = o; }
    asm volatile("s_waitcnt lgkmcnt(0)" ::: "memory");
}

__device__ __forceinline__ void phase_modpart(Frame& F, const float* c, const float* w_mod, float* modpart) {
    int vcu_ = F.vcu, gw_ = F.gw; asm volatile("" : "+s"(vcu_), "+s"(gw_)); (void)vcu_; (void)gw_;
    const int tid_ = fresh_tid(), lane_ = tid_ & 63; (void)tid_; (void)lane_;
    LAS float* red = (LAS float*)F.lds;
    for (int item = vcu_; item < 256; item += F.G) {
        const int cg = item & 63, ks = item >> 6;
        const int cq = tid_ % 48, rg = tid_ / 48;
        float a[4][4];
#pragma unroll
        for (int b = 0; b < 4; ++b)
#pragma unroll
            for (int j = 0; j < 4; ++j) a[b][j] = 0.f;
        if (rg < 10) {
            for (int k = ks * 512 + rg; k < ks * 512 + 512; k += 10) {
                const f32x4 w = *(const f32x4*)(w_mod + (size_t)k * NMOD + cg * 192 + cq * 4);
#pragma unroll
                for (int b = 0; b < 4; ++b) { const float s = silu_f(c[b * DM + k]);
#pragma unroll
                    for (int j = 0; j < 4; ++j) a[b][j] += s * w[j]; }
            }
#pragma unroll
            for (int b = 0; b < 4; ++b)
#pragma unroll
                for (int j = 0; j < 4; ++j) red[(rg * 4 + b) * 192 + cq * 4 + j] = a[b][j];
        }
        __syncthreads();
        for (int o = tid_; o < 4 * 192; o += 512) { const int b = o / 192, col = o % 192; float s = 0.f;
            for (int r = 0; r < 10; ++r) s += red[(r * 4 + b) * 192 + col];
            modpart[((size_t)ks * 4 + b) * NMOD + cg * 192 + col] = s; }
        __syncthreads();
    }
}

__device__ __forceinline__ void phase_prep(Frame& F, const ArgV A) {
    int vcu_ = F.vcu, gw_ = F.gw; asm volatile("" : "+s"(vcu_), "+s"(gw_)); (void)vcu_; (void)gw_;
    const int tid_ = fresh_tid(), lane_ = tid_ & 63; (void)tid_; (void)lane_;
    const float* modpart = (const float*)(A.ws() + WS_MODPART); float* modv = (float*)(A.ws() + WS_MODV);
    const float *b_mod = A.in(3), *mod_layer = A.in(4), *norm1_g = A.in(5), *norm2_g = A.in(14);
    for (int idx = vcu_ * 512 + tid_; idx < NL * NB * 6 * DM; idx += F.G * 512) {
        const int col = idx % DM, which = (idx / DM) % 6, b = (idx / (6 * DM)) % NB, l = idx / (6 * DM * NB);
        const int n = which * DM + col;
        float m = b_mod[n] + mod_layer[l * NMOD + n];
#pragma unroll
        for (int ks = 0; ks < 4; ++ks) m += modpart[((size_t)ks * 4 + b) * NMOD + n];
        float o = m;
        if (which == 1) o = norm1_g[l * DM + col] * (1.f + m);
        if (which == 4) o = norm2_g[l * DM + col] * (1.f + m);
        modv[idx] = o;
    }
    {
        const float *w_group = A.in(15), *w_route = A.in(17); bf16_t* WrT = (bf16_t*)(A.ws() + WS_WRT);
        for (int idx = vcu_ * 512 + tid_; idx < NL * 64 * DM; idx += F.G * 512) {
            const int k = idx % DM, rho = (idx / DM) % 64, l = idx / (64 * DM);
            float val = 0.f;
            if (rho < 16) val = w_route[((size_t)l * DM + k) * 32 + 8 * (rho >> 2) + (rho & 3)];
            else if (rho < 32) val = w_route[((size_t)l * DM + k) * 32 + 8 * ((rho - 16) >> 2) + 4 + (rho & 3)];
            else if (rho < 48) val = w_group[((size_t)l * DM + k) * 4 + (rho & 3)];
            WrT[idx] = (bf16_t)f2bf(val);
        }
    }
    {
        const float* gm_ws = A.in(8); bf16_t* Wgm = (bf16_t*)(A.ws() + WS_WGM);
        for (int idx = vcu_ * 512 + tid_; idx < NL * 4 * 128 * 128; idx += F.G * 512) { const int p = idx & 127, t = (idx >> 7) & 127; Wgm[idx] = (p <= t) ? (bf16_t)f2bf(gm_ws[idx]) : (bf16_t)0; }
    }
    LAS float* scr = (LAS float*)(F.lds + F.wave * 16640);
    constexpr int I_IN = NL * 32 * 40, I_OUT = NL * 16 * 32, I_GU = NL * NE * 2 * 32 * 4, I_DN = NL * NE * 4 * 32;
    const float *w_in = A.in(6), *w_out = A.in(13), *w_gate = A.in(19), *w_up = A.in(20), *w_down = A.in(21);
    bf16_t* WinT = (bf16_t*)(A.ws() + WS_WINT); bf16_t* WoutT = (bf16_t*)(A.ws() + WS_WOUTT); bf16_t* WguT = (bf16_t*)(A.ws() + WS_WGUT); bf16_t* WdT = (bf16_t*)(A.ws() + WS_WDT);
    for (int it = gw_; it < I_IN + I_OUT + I_GU + I_DN; it += F.NGW) {
        int r = it;
        if (r < I_IN) { const int l = r / (32 * 40), q = r % (32 * 40), kb = q / 40, nb = q % 40;
            transpose_item(w_in + (size_t)l * DM * DIN, DIN, 64 * kb, 64 * nb, WinT + (size_t)l * DIN * DM, DM, 64 * nb, scr, lane_); continue; }
        r -= I_IN;
        if (r < I_OUT) { const int l = r / (16 * 32), q = r % (16 * 32), kb = q / 32, nb = q % 32;
            transpose_item(w_out + (size_t)l * DMIX * DM, DM, 64 * kb, 64 * nb, WoutT + (size_t)l * DM * DMIX, DMIX, 64 * nb, scr, lane_); continue; }
        r -= I_OUT;
        if (r < I_GU) { const int le = r / 256, q = r % 256, up = q >> 7, kb = (q & 127) >> 2, nb = q & 3;
            const float* src = (up ? w_up : w_gate) + (size_t)le * DM * DE;
            const int n0 = 64 * nb, drow0 = 256 * (n0 >> 7) + (n0 & 127) + 128 * up;
            transpose_item(src, DE, 64 * kb, n0, WguT + (size_t)le * 512 * DM, DM, drow0, scr, lane_); continue; }
        r -= I_GU;
        { const int le = r / 128, q = r % 128, kb = q >> 5, nb = q & 31;
            transpose_item(w_down + (size_t)le * DE * DM, DM, 64 * kb, 64 * nb, WdT + (size_t)le * DM * DE, DE, 64 * nb, scr, lane_); }
    }
}

#define TB(kind) do { if ((kind) == PROBE_KIND && blockIdx.x == PROBE_BLOCK && threadIdx.x == 0) { const unsigned long long t_ = __builtin_amdgcn_s_memrealtime(); F.MISC[200] = (unsigned)t_; F.MISC[201] = (unsigned)(t_ >> 32); } } while (0)
#define TE(kind) do { if ((kind) == PROBE_KIND && blockIdx.x == PROBE_BLOCK && threadIdx.x == 0) { const unsigned long long t_ = __builtin_amdgcn_s_memrealtime() - (((unsigned long long)F.MISC[201] << 32) | F.MISC[200]); \
        const unsigned long long a_ = (((unsigned long long)F.MISC[203] << 32) | F.MISC[202]) + t_; F.MISC[202] = (unsigned)a_; F.MISC[203] = (unsigned)(a_ >> 32); } } while (0)
__device__ __forceinline__ void build_tiles(Frame& F, int lc) {
    const int tid_ = fresh_tid(), lane_ = tid_ & 63; (void)tid_; (void)lane_;
    __syncthreads();
    if (tid_ < 32) { const unsigned n = __hip_atomic_load(F.ctl + CW_CNT + (lc * 32 + tid_) * 64, RLX_AGENT); F.MISC[64 + tid_] = n; }
    __syncthreads();
    if (tid_ == 0) { unsigned p = 0; for (int e = 0; e < 32; ++e) { F.MISC[16 + e] = p; p += (F.MISC[64 + e] + 255u) >> 8; } F.MISC[16 + 32] = p; }
    __syncthreads();
    if (tid_ < 32) { volatile LAS unsigned* te = (volatile LAS unsigned*)(F.lds + TILE_E_OFF); const unsigned a = F.MISC[16 + tid_], b = F.MISC[17 + tid_]; for (unsigned t = a; t < b; ++t) te[t] = (unsigned)tid_; }
    __syncthreads();
}

template <int MODE>
__device__ __forceinline__ void phase_norm1(Frame& F, const ArgV A, int l) {
    int vcu_ = F.vcu; asm volatile("" : "+s"(vcu_));
    const int tid_ = fresh_tid(), lane_ = tid_ & 63; (void)tid_;
    const float* modv = (const float*)(A.ws() + WS_MODV);
    const unsigned char* yslot = (const unsigned char*)(A.ws() + WS_YSLOT); bf16_t* hout = (bf16_t*)A.out(); bf16_t* xb = (bf16_t*)(A.ws() + WS_XB);
    const float* xin = A.in(0); float* outf = A.out();
    const int* tok = (const int*)(A.ws() + WS_TOK);
    if (MODE != 0) build_tiles(F, l - 1);
    for (int blk = vcu_; blk < NT / 128; blk += F.G) {
        const int b = (blk * 128) / SEQ;
        const float* mA_ = modv + ((size_t)((MODE != 2 ? l : 0) * NB + b) * 6 + 1) * DM;
        const float* mS_ = modv + ((size_t)((MODE != 2 ? l : 0) * NB + b) * 6 + 0) * DM;
        const float* mG_ = modv + ((size_t)((MODE != 0 ? l - 1 : 0) * NB + b) * 6 + 5) * DM;
        int s0v = 0, s1v = 0; float w0v = 0.f, w1v = 0.f;
        if (MODE != 0) { const int rr = blk * 128 + F.wave * 16 + (lane_ & 15); const int* tr = tok + (size_t)rr * 8;
            const int e0 = tr[0], e1 = tr[1], p0 = tr[2], p1 = tr[3]; w0v = __builtin_bit_cast(float, tr[4]); w1v = __builtin_bit_cast(float, tr[5]);
            s0v = (int)F.MISC[16 + e0] * 256 + p0; s1v = (int)F.MISC[16 + e1] * 256 + p1; }
#pragma unroll 1
        for (int i = 0; i < 16; i += 2) {
            const int row = blk * 128 + F.wave * 16 + i;
            const float *mA = mA_, *mS = mS_, *mG = mG_;
            asm volatile("" : "+s"(mA), "+s"(mS), "+s"(mG));
            f32x4 v[2][8];
            if (MODE == 0) {
#pragma unroll
                for (int r = 0; r < 2; ++r) { const f32x4* xr = (const f32x4*)(xin + (size_t)(row + r) * DM) + lane_;
#pragma unroll
                    for (int j = 0; j < 8; ++j) v[r][j] = xr[64 * j]; } }
            else {
                u32x2 xw[2][8]; unsigned ya[2][8], yc[2][8]; float cw0[2], cw1[2];
#pragma unroll
                for (int r = 0; r < 2; ++r) { const int s0 = __shfl(s0v, i + r), s1 = __shfl(s1v, i + r); cw0[r] = __shfl(w0v, i + r); cw1[r] = __shfl(w1v, i + r);
                    const u32x2* xr = (const u32x2*)(xb + (size_t)(row + r) * DM) + lane_;
                    const unsigned* y0 = (const unsigned*)(yslot + (size_t)s0 * DM) + lane_; const unsigned* y1 = (const unsigned*)(yslot + (size_t)s1 * DM) + lane_;
#pragma unroll
                    for (int j = 0; j < 8; ++j) { xw[r][j] = xr[64 * j]; ya[r][j] = y0[64 * j]; yc[r][j] = y1[64 * j]; } }
#pragma unroll
                for (int j = 0; j < 8; ++j) { const f32x4 g = *((const f32x4*)mG + lane_ + 64 * j);
#pragma unroll
                    for (int r = 0; r < 2; ++r) { const u32x2 w = xw[r][j]; const int a = (int)ya[r][j], c = (int)yc[r][j]; const float w0 = cw0[r], w1 = cw1[r];
                        v[r][j][0] = bflo(w.x) + g[0] * (w0 * __builtin_amdgcn_cvt_f32_fp8(a, 0) + w1 * __builtin_amdgcn_cvt_f32_fp8(c, 0));
                        v[r][j][1] = bfhi(w.x) + g[1] * (w0 * __builtin_amdgcn_cvt_f32_fp8(a, 1) + w1 * __builtin_amdgcn_cvt_f32_fp8(c, 1));
                        v[r][j][2] = bflo(w.y) + g[2] * (w0 * __builtin_amdgcn_cvt_f32_fp8(a, 2) + w1 * __builtin_amdgcn_cvt_f32_fp8(c, 2));
                        v[r][j][3] = bfhi(w.y) + g[3] * (w0 * __builtin_amdgcn_cvt_f32_fp8(a, 3) + w1 * __builtin_amdgcn_cvt_f32_fp8(c, 3)); } }
            }
            if (MODE == 2) {
#pragma unroll
                for (int r = 0; r < 2; ++r) { f32x4* xo = (f32x4*)(outf + (size_t)(row + r) * DM) + lane_;
#pragma unroll
                    for (int j = 0; j < 8; ++j) xo[64 * j] = v[r][j]; } }
            else {
                float ss[2] = {0.f, 0.f};
#pragma unroll
                for (int r = 0; r < 2; ++r) { u32x2* xo = (u32x2*)(xb + (size_t)(row + r) * DM) + lane_;
#pragma unroll
                    for (int j = 0; j < 8; ++j) { u32x2 o; o.x = pk2(v[r][j][0], v[r][j][1]); o.y = pk2(v[r][j][2], v[r][j][3]); xo[64 * j] = o;
                        v[r][j] = (f32x4){bflo(o.x), bfhi(o.x), bflo(o.y), bfhi(o.y)};
                        ss[r] += (v[r][j][0] * v[r][j][0] + v[r][j][1] * v[r][j][1]) + (v[r][j][2] * v[r][j][2] + v[r][j][3] * v[r][j][3]); } }
#pragma unroll
                for (int o = 1; o < 64; o <<= 1) { ss[0] += __shfl_xor(ss[0], o); ss[1] += __shfl_xor(ss[1], o); }
                const float rstd0 = 1.f / sqrtf(ss[0] * (1.f / DM) + EPS), rstd1 = 1.f / sqrtf(ss[1] * (1.f / DM) + EPS);
                u32x2* ho0 = (u32x2*)(hout + (size_t)row * DM) + lane_; u32x2* ho1 = ho0 + DM / 4;
#pragma unroll
                for (int j = 0; j < 8; ++j) { const f32x4 a = *((const f32x4*)mA + lane_ + 64 * j), sh = *((const f32x4*)mS + lane_ + 64 * j);
                    u32x2 o; o.x = pk2(v[0][j][0] * rstd0 * a[0] + sh[0], v[0][j][1] * rstd0 * a[1] + sh[1]); o.y = pk2(v[0][j][2] * rstd0 * a[2] + sh[2], v[0][j][3] * rstd0 * a[3] + sh[3]); ho0[64 * j] = o;
                    u32x2 p; p.x = pk2(v[1][j][0] * rstd1 * a[0] + sh[0], v[1][j][1] * rstd1 * a[1] + sh[1]); p.y = pk2(v[1][j][2] * rstd1 * a[2] + sh[2], v[1][j][3] * rstd1 * a[3] + sh[3]); ho1[64 * j] = p; }
            }
        }
    }
}

__device__ __forceinline__ int crow(int r, int h) { return (r & 3) + 8 * (r >> 2) + 4 * h; }
__device__ __forceinline__ unsigned off_b(unsigned row, unsigned ch) { return 256u * row + 16u * (ch ^ (((row & 3u) << 2) | ((row >> 2) & 3u))); }
typedef short s16x4 __attribute__((ext_vector_type(4)));
__device__ __forceinline__ s16x4 vtr(const LAS unsigned char* p) { return __builtin_bit_cast(s16x4, __builtin_amdgcn_ds_read_tr16_b64_v4i16((LAS s16x4*)p)); }
__device__ __forceinline__ bf16x8 pack8(float a0, float a1, float a2, float a3, float a4, float a5, float a6, float a7) {
    u32x4 p; p.x = pk2(a0, a1); p.y = pk2(a2, a3); p.z = pk2(a4, a5); p.w = pk2(a6, a7); return __builtin_bit_cast(bf16x8, p); }
__device__ __forceinline__ float gelu_fast(float v) {
    const float av = __builtin_fabsf(v), t = __builtin_amdgcn_rcpf(av * 0.2316418882f + 1.0f);
    float q = t * 0.5307027145f + (-0.7265760135f); q = q * t + 0.7107068705f; q = q * t + (-0.142248368f); q = q * t + 0.127414796f; q = q * t;
    const float e = __builtin_amdgcn_exp2f((v * v) * (-0.72134752044f));
    const float m = v * (q * e);
    return v < 0.f ? m : v - m;
}
__device__ __forceinline__ void phase_gmlp(Frame& F, const ArgV A, int l) {
    int vcu_ = F.vcu; asm volatile("" : "+s"(vcu_));
    const int tid_ = fresh_tid(), lane = tid_ & 63, r32 = lane & 31, hh = lane >> 5;
    const bf16_t* proj = (const bf16_t*)(A.ws() + WS_PROJ); bf16_t* ymix = (bf16_t*)(A.ws() + WS_YMIX);
    const float *gm_norm_g = A.in(7) + l * 512, *gm_bs = A.in(9) + l * 512, *out_norm_g = A.in(12) + l * DMIX;
    const bf16_t* Wgm = (const bf16_t*)(A.ws() + WS_WGM) + (size_t)l * 4 * 128 * 128;
    LAS unsigned char* vimg = F.lds;
    LAS float* red = (LAS float*)(F.lds + 32768);
    const unsigned blk16 = (lane >> 4) & 1, tq = (lane & 15) >> 2, tp = lane & 3;
    const int tb = F.wave >> 1, kh = F.wave & 1;
    const int p = tid_ >> 2, seg = tid_ & 3;
    const int NU = NT / 128 * 4;
    u32x4 vw[4];
    if (vcu_ < NU) { const int g0 = vcu_ & 3, row00 = (vcu_ >> 2) * 128; const u32x4* vp = (const u32x4*)(proj + (size_t)(row00 + p) * DIN + 512 + g0 * 128 + seg * 32);
#pragma unroll
        for (int c = 0; c < 4; ++c) vw[c] = vp[c]; }
    for (int u = vcu_; u < NU; u += F.G) {
        const int g = u & 3, ch = u >> 2, row0 = ch * 128;
        {
            float x[32]; float ss = 0.f;
#pragma unroll
            for (int c = 0; c < 4; ++c) { const u32x4 w = vw[c];
                x[c * 8 + 0] = bflo(w.x); x[c * 8 + 1] = bfhi(w.x); x[c * 8 + 2] = bflo(w.y); x[c * 8 + 3] = bfhi(w.y);
                x[c * 8 + 4] = bflo(w.z); x[c * 8 + 5] = bfhi(w.z); x[c * 8 + 6] = bflo(w.w); x[c * 8 + 7] = bfhi(w.w); }
#pragma unroll
            for (int j = 0; j < 32; ++j) { x[j] = gelu_fast(x[j]); ss += x[j] * x[j]; }
            ss += __shfl_xor(ss, 1); ss += __shfl_xor(ss, 2);
            const float rv = 1.f / sqrtf(ss * (1.f / 128.f) + EPS);
            const float* gn = gm_norm_g + g * 128 + seg * 32;
#pragma unroll
            for (int c = 0; c < 4; ++c) { const f32x4 ga = *(const f32x4*)(gn + 8 * c), gb = *(const f32x4*)(gn + 8 * c + 4);
                *(LAS bf16x8*)(vimg + off_b((unsigned)p, (unsigned)(4 * seg + c))) = pack8(x[8 * c] * rv * ga[0], x[8 * c + 1] * rv * ga[1], x[8 * c + 2] * rv * ga[2], x[8 * c + 3] * rv * ga[3],
                                                                                         x[8 * c + 4] * rv * gb[0], x[8 * c + 5] * rv * gb[1], x[8 * c + 6] * rv * gb[2], x[8 * c + 7] * rv * gb[3]); }
        }
        const int t = 32 * tb + r32;
        { const int un = u + F.G; if (un < NU) { const int gn_ = un & 3, rown = (un >> 2) * 128; const u32x4* vp = (const u32x4*)(proj + (size_t)(rown + p) * DIN + 512 + gn_ * 128 + seg * 32);
#pragma unroll
            for (int c = 0; c < 4; ++c) vw[c] = vp[c]; } }
        u32x2 uw[2][4];
#pragma unroll
        for (int kb = 0; kb < 2; ++kb)
#pragma unroll
            for (int g4 = 0; g4 < 4; ++g4) uw[kb][g4] = *(const u32x2*)(proj + (size_t)(row0 + t) * DIN + g * 128 + 64 * kh + 32 * kb + 8 * g4 + 4 * hh);
        const bf16x8* wrow = (const bf16x8*)(Wgm + ((size_t)g * 128 + t) * 128 + 8 * hh);
        bf16x8 wf[8];
#pragma unroll
        for (int j = 0; j < 8; ++j) wf[j] = (j < 2 * (tb + 1)) ? wrow[2 * j] : (bf16x8){0, 0, 0, 0, 0, 0, 0, 0};
        const float bias = gm_bs[g * 128 + t];
        __syncthreads();
        f32x16 acc[2];
#pragma unroll
        for (int kb = 0; kb < 2; ++kb)
#pragma unroll
            for (int q = 0; q < 16; ++q) acc[kb][q] = 0.f;
#pragma unroll
        for (int j = 0; j < 8; ++j) {
            if (j < 2 * (tb + 1)) {
#pragma unroll
                for (int kb = 0; kb < 2; ++kb) {
                    const unsigned ra = (unsigned)(16 * j + 8 * hh) + tq, rb = ra + 4u, cc = (unsigned)(2 * kh + kb);
                    const s16x4 lo4 = vtr(vimg + off_b(ra, 4u * cc + 2u * blk16 + (tp >> 1)) + 8u * (tp & 1));
                    const s16x4 hi4 = vtr(vimg + off_b(rb, 4u * cc + 2u * blk16 + (tp >> 1)) + 8u * (tp & 1));
                    const bf16x8 af = __builtin_shufflevector(lo4, hi4, 0, 1, 2, 3, 4, 5, 6, 7);
                    acc[kb] = __builtin_amdgcn_mfma_f32_32x32x16_bf16(af, wf[j], acc[kb], 0, 0, 0);
                }
            }
        }
        float ss = 0.f;
#pragma unroll
        for (int kb = 0; kb < 2; ++kb)
#pragma unroll
            for (int g4 = 0; g4 < 4; ++g4) { const u32x2 w = uw[kb][g4];
                const float u0 = gelu_fast(bflo(w.x)), u1 = gelu_fast(bfhi(w.x)), u2 = gelu_fast(bflo(w.y)), u3 = gelu_fast(bfhi(w.y));
                float y0 = u0 * (acc[kb][4 * g4] + bias), y1 = u1 * (acc[kb][4 * g4 + 1] + bias), y2 = u2 * (acc[kb][4 * g4 + 2] + bias), y3 = u3 * (acc[kb][4 * g4 + 3] + bias);
                acc[kb][4 * g4] = y0; acc[kb][4 * g4 + 1] = y1; acc[kb][4 * g4 + 2] = y2; acc[kb][4 * g4 + 3] = y3;
                ss += (y0 * y0 + y1 * y1) + (y2 * y2 + y3 * y3); }
        ss += __shfl_xor(ss, 32);
        if (hh == 0) red[F.wave * 32 + r32] = ss;
        __syncthreads();
        const float tot = red[(2 * tb) * 32 + r32] + red[(2 * tb + 1) * 32 + r32];
        const float ry = 1.f / sqrtf(tot * (1.f / 128.f) + EPS);
#pragma unroll
        for (int kb = 0; kb < 2; ++kb)
#pragma unroll
            for (int g4 = 0; g4 < 4; ++g4) { const int k0 = 64 * kh + 32 * kb + 8 * g4 + 4 * hh; const f32x4 og = *(const f32x4*)(out_norm_g + g * 128 + k0);
                u32x2 w; w.x = pk2(acc[kb][4 * g4] * ry * og[0], acc[kb][4 * g4 + 1] * ry * og[1]); w.y = pk2(acc[kb][4 * g4 + 2] * ry * og[2], acc[kb][4 * g4 + 3] * ry * og[3]);
                *(u32x2*)(ymix + (size_t)(row0 + t) * DMIX + g * 128 + k0) = w; }
        __syncthreads();
    }
}

__device__ __forceinline__ void glds16(const void* gsrc, unsigned lds_dst) { unsigned keep;
    asm volatile("s_mov_b32 %0, m0\n\ts_mov_b32 m0, %2\n\ts_nop 0\n\tglobal_load_lds_dwordx4 %1, off\n\ts_mov_b32 m0, %0" : "=&s"(keep) : "v"(gsrc), "s"(lds_dst) : "memory"); }
__device__ __forceinline__ void phase_attn(Frame& F, const ArgV A, int l) {
    int gw_ = F.gw; asm volatile("" : "+s"(gw_));
    const int tid_ = fresh_tid(), lane = tid_ & 63, r32 = lane & 31, hh = lane >> 5;
    const bf16_t* proj = (const bf16_t*)(A.ws() + WS_PROJ); bf16_t* ymix = (bf16_t*)(A.ws() + WS_YMIX); const float* ksq = (const float*)(A.ws() + WS_KSQ);
    const float *qg = A.in(10) + l * 128, *kg = A.in(11) + l * 128, *out_norm_g = A.in(12) + l * DMIX;
    LAS unsigned char* kimg = F.lds + F.wave * 17536;
    LAS unsigned char* vimg = kimg + 8192;
    LAS float* rkraw = (LAS float*)(kimg + 16384);
    LAS float* rkbuf = (LAS float*)(kimg + 17408);
    const unsigned kimg_lds = (unsigned)(size_t)kimg;
    const float c2 = 1.4426950408889634f * 0.08838834764831845f;
    LAS float* gqk = (LAS float*)(F.lds + 8 * 17536);
    __syncthreads();
    if (tid_ < 128) gqk[tid_] = qg[tid_] * kg[tid_] * c2;
    __syncthreads();
    bf16x8 tf[2];
#pragma unroll
    for (int s = 0; s < 2; ++s)
#pragma unroll
        for (int j = 0; j < 8; ++j) tf[s][j] = ((16 * s + 8 * (j >> 2) + 4 * hh + (j & 3)) >= r32) ? (short)0x3F80 : (short)0;
    const unsigned blk16 = (lane >> 4) & 1, tq = (lane & 15) >> 2, tp = lane & 3;
    for (int u = gw_; u < NB * 4 * (SEQ / 32); u += F.NGW) {
        const int qb = u % (SEQ / 32), hd = (u / (SEQ / 32)) & 3, b = u / (4 * (SEQ / 32));
        const size_t rowq = (size_t)b * SEQ + qb * 32 + r32;
        bf16x8 qf[8];
        {
            const f32x4 qs4 = *(const f32x4*)(ksq + (rowq * 8 + hd) * 4);
            const float rq = 1.f / sqrtf(((qs4[0] + qs4[1]) + (qs4[2] + qs4[3])) * (1.f / 128.f) + EPS);
            const u32x4* qp = (const u32x4*)(proj + rowq * DIN + 1024 + hd * 128 + 8 * hh);
#pragma unroll
            for (int s = 0; s < 8; ++s) { const u32x4 w = qp[2 * s]; const int d0 = 16 * s + 8 * hh;
                const f32x4 ga = *(const LAS f32x4*)(gqk + d0), gb = *(const LAS f32x4*)(gqk + d0 + 4);
                qf[s] = pack8(bflo(w.x) * rq * ga[0], bfhi(w.x) * rq * ga[1], bflo(w.y) * rq * ga[2], bfhi(w.y) * rq * ga[3],
                              bflo(w.z) * rq * gb[0], bfhi(w.z) * rq * gb[1], bflo(w.w) * rq * gb[2], bfhi(w.w) * rq * gb[3]); }
        }
        f32x16 o[4];
#pragma unroll
        for (int db = 0; db < 4; ++db)
#pragma unroll
            for (int q = 0; q < 16; ++q) o[db][q] = 0.f;
        float R = 0.f;
#define ATT_DMA_K(kt_) do { const size_t rk0_ = (size_t)b * SEQ + (size_t)(kt_) * 32; \
            _Pragma("unroll") for (int i_ = 0; i_ < 8; ++i_) { const unsigned row_ = 4u * i_ + (lane >> 4), ch_ = (lane & 15u) ^ (((row_ & 3u) << 2) | ((row_ >> 2) & 3u)); \
                glds16(proj + (rk0_ + row_) * DIN + 1536 + hd * 128 + 8 * ch_, (unsigned)__builtin_amdgcn_readfirstlane((int)(kimg_lds + i_ * 1024u))); } \
            glds16(ksq + ((rk0_ + (lane & 31)) * 8 + 4 + hd) * 4, (unsigned)__builtin_amdgcn_readfirstlane((int)(kimg_lds + 16384u)) ); } while (0)
#define ATT_DMA_V(kt_) do { const size_t rk0_ = (size_t)b * SEQ + (size_t)(kt_) * 32; \
            _Pragma("unroll") for (int i_ = 0; i_ < 8; ++i_) { const unsigned row_ = 4u * i_ + (lane >> 4), ch_ = (lane & 15u) ^ (((row_ & 3u) << 2) | ((row_ >> 2) & 3u)); \
                glds16(proj + (rk0_ + row_) * DIN + 2048 + hd * 128 + 8 * ch_, (unsigned)__builtin_amdgcn_readfirstlane((int)(kimg_lds + 8192u + i_ * 1024u))); } } while (0)
        asm volatile("s_waitcnt vmcnt(0)" ::: "memory");
        ATT_DMA_K(qb); ATT_DMA_V(qb);
        TB(21);
#pragma unroll 1
        for (int kt = qb; kt >= 0; --kt) {
            TB(22);
            asm volatile("s_waitcnt vmcnt(8)" ::: "memory");
            TE(22);
            bf16x8 kf[8];
#pragma unroll
            for (int s = 0; s < 8; ++s) kf[s] = *(const LAS bf16x8*)(kimg + off_b((unsigned)r32, (unsigned)(2 * s + hh)));
            { const f32x4 k4 = *(const LAS f32x4*)(rkraw + 4 * r32);
              if (lane < 32) rkbuf[lane] = 1.f / sqrtf(((k4[0] + k4[1]) + (k4[2] + k4[3])) * (1.f / 128.f) + EPS); }
            asm volatile("s_waitcnt lgkmcnt(0)" ::: "memory");
            if (kt > 0) { ATT_DMA_K(kt - 1); }
            f32x16 z;
#pragma unroll
            for (int q = 0; q < 16; ++q) z[q] = 0.f;
#pragma unroll
            for (int s = 0; s < 8; ++s) z = __builtin_amdgcn_mfma_f32_32x32x16_bf16(kf[s], qf[s], z, 0, 0, 0);
            f32x16 Lh;
            const bool diag = (kt == qb);
#pragma unroll
            for (int g = 0; g < 4; ++g) { const f32x4 rk4 = *(const LAS f32x4*)(rkbuf + 8 * g + 4 * hh);
#pragma unroll
                for (int e = 0; e < 4; ++e) { const int q = 4 * g + e; const float z2 = z[q] * rk4[e]; z[q] = z2 + R;
                    const bool valid = !diag || (crow(q, hh) < r32);
                    Lh[q] = valid ? -__builtin_amdgcn_logf(1.f + __builtin_amdgcn_exp2f(z2)) : 0.f; } }
            const float seed0 = z[0];
#pragma unroll
            for (int s = 0; s < 2; ++s) {
                const bf16x8 lhi = pack8(Lh[8 * s], Lh[8 * s + 1], Lh[8 * s + 2], Lh[8 * s + 3], Lh[8 * s + 4], Lh[8 * s + 5], Lh[8 * s + 6], Lh[8 * s + 7]);
                float lo[8];
#pragma unroll
                for (int j = 0; j < 8; ++j) lo[j] = Lh[8 * s + j] - __builtin_bit_cast(float, ((unsigned)(unsigned short)lhi[j]) << 16);
                const bf16x8 llo = pack8(lo[0], lo[1], lo[2], lo[3], lo[4], lo[5], lo[6], lo[7]);
                z = __builtin_amdgcn_mfma_f32_32x32x16_bf16(tf[s], lhi, z, 0, 0, 0);
                z = __builtin_amdgcn_mfma_f32_32x32x16_bf16(tf[s], llo, z, 0, 0, 0);
            }
            const float tot = z[0] - seed0;
#pragma unroll
            for (int q = 0; q < 16; ++q) { const bool valid = !diag || (crow(q, hh) < r32); const float a = __builtin_amdgcn_exp2f(z[q]); z[q] = valid ? a : 0.f; }
            R += __shfl(tot, r32);
            TB(23);
            if (kt > 0) asm volatile("s_waitcnt vmcnt(9)" ::: "memory"); else asm volatile("s_waitcnt vmcnt(0)" ::: "memory");
            TE(23);
#pragma unroll
            for (int s = 0; s < 2; ++s) {
                const bf16x8 pf = pack8(z[8 * s], z[8 * s + 1], z[8 * s + 2], z[8 * s + 3], z[8 * s + 4], z[8 * s + 5], z[8 * s + 6], z[8 * s + 7]);
                bf16x8 vf[4];
#pragma unroll
                for (int db = 0; db < 4; ++db) {
                    const unsigned ra = (unsigned)(16 * s + 4 * hh) + tq, rb = ra + 8u;
                    const s16x4 lo4 = vtr(vimg + off_b(ra, 4u * db + 2u * blk16 + (tp >> 1)) + 8u * (tp & 1));
                    const s16x4 hi4 = vtr(vimg + off_b(rb, 4u * db + 2u * blk16 + (tp >> 1)) + 8u * (tp & 1));
                    vf[db] = __builtin_shufflevector(lo4, hi4, 0, 1, 2, 3, 4, 5, 6, 7);
                }
#pragma unroll
                for (int db = 0; db < 4; ++db) o[db] = __builtin_amdgcn_mfma_f32_32x32x16_bf16(vf[db], pf, o[db], 0, 0, 0);
            }
            if (PROBE_KIND == 20 && blockIdx.x == 128 && tid_ == 0) F.MISC[204] = F.MISC[204] + 1u;
            asm volatile("s_waitcnt lgkmcnt(0)" ::: "memory");
            if (kt > 0) { ATT_DMA_V(kt - 1); }
            if (__builtin_amdgcn_ballot_w64(R >= -150.f) == 0ull) break;
        }
#undef ATT_DMA_K
#undef ATT_DMA_V
        TE(21);
        asm volatile("s_waitcnt vmcnt(0)" ::: "memory");
        float ss = 0.f;
#pragma unroll
        for (int db = 0; db < 4; ++db)
#pragma unroll
            for (int q = 0; q < 16; ++q) ss += o[db][q] * o[db][q];
        ss += __shfl_xor(ss, 32);
        const float rs = 1.f / sqrtf(ss * (1.f / 128.f) + EPS);
        bf16_t* yo = ymix + rowq * DMIX + 512 + hd * 128;
        const float* og = out_norm_g + 512 + hd * 128;
#pragma unroll
        for (int db = 0; db < 4; ++db)
#pragma unroll
            for (int g = 0; g < 4; ++g) { const int d0 = 32 * db + 8 * g + 4 * hh; const f32x4 gg = *(const f32x4*)(og + d0);
                u32x2 w; w.x = pk2(o[db][4 * g] * rs * gg[0], o[db][4 * g + 1] * rs * gg[1]); w.y = pk2(o[db][4 * g + 2] * rs * gg[2], o[db][4 * g + 3] * rs * gg[3]);
                *(u32x2*)(yo + d0) = w; }
    }
}

__device__ __forceinline__ void phase_router(Frame& F, const ArgV A, int l) {
    int vcu_ = F.vcu; asm volatile("" : "+s"(vcu_));
    const int tid_ = fresh_tid(), lane = tid_ & 63;
    const float* modv = (const float*)(A.ws() + WS_MODV); bf16_t* hout = (bf16_t*)A.out(); const bf16_t* xb = (const bf16_t*)(A.ws() + WS_XB);
    int* tok = (int*)(A.ws() + WS_TOK); int* list = (int*)(A.ws() + WS_LIST);
    const bf16_t* WrT = (const bf16_t*)(A.ws() + WS_WRT) + (size_t)l * 64 * DM;
    const float *b_group = A.in(16) + l * 4, *b_route = A.in(18) + l * 32;
    volatile LAS unsigned* lcnt = F.MISC + 128;
    for (int blk = vcu_; blk < NT / 128; blk += F.G) {
        const int b = (blk * 128) / SEQ;
        const float* mA_ = modv + ((size_t)(l * NB + b) * 6 + 4) * DM; const float* mS_ = modv + ((size_t)(l * NB + b) * 6 + 3) * DM;
        if (tid_ < 64) lcnt[tid_] = 0u;
#pragma unroll 1
        for (int i = 0; i < 16; i += 4) {
            const int row = blk * 128 + F.wave * 16 + i;
            const float *mA = mA_, *mS = mS_;
            asm volatile("" : "+s"(mA), "+s"(mS));
            u32x2 xw[4][8];
#pragma unroll
            for (int r = 0; r < 4; ++r) { const u32x2* xr = (const u32x2*)(xb + (size_t)(row + r) * DM) + lane;
#pragma unroll
                for (int j = 0; j < 8; ++j) xw[r][j] = xr[64 * j]; }
            float ss[4] = {0.f, 0.f, 0.f, 0.f};
#pragma unroll
            for (int r = 0; r < 4; ++r)
#pragma unroll
                for (int j = 0; j < 8; ++j) { const float a0 = bflo(xw[r][j].x), a1 = bfhi(xw[r][j].x), a2 = bflo(xw[r][j].y), a3 = bfhi(xw[r][j].y); ss[r] += (a0 * a0 + a1 * a1) + (a2 * a2 + a3 * a3); }
#pragma unroll
            for (int o = 1; o < 64; o <<= 1) { ss[0] += __shfl_xor(ss[0], o); ss[1] += __shfl_xor(ss[1], o); ss[2] += __shfl_xor(ss[2], o); ss[3] += __shfl_xor(ss[3], o); }
            float rstd[4];
#pragma unroll
            for (int r = 0; r < 4; ++r) rstd[r] = 1.f / sqrtf(ss[r] * (1.f / DM) + EPS);
#pragma unroll
            for (int j = 0; j < 8; ++j) { const f32x4 a = *((const f32x4*)mA + lane + 64 * j), sh = *((const f32x4*)mS + lane + 64 * j);
#pragma unroll
                for (int r = 0; r < 4; ++r) { u32x2 o; o.x = pk2(bflo(xw[r][j].x) * rstd[r] * a[0] + sh[0], bfhi(xw[r][j].x) * rstd[r] * a[1] + sh[1]);
                    o.y = pk2(bflo(xw[r][j].y) * rstd[r] * a[2] + sh[2], bfhi(xw[r][j].y) * rstd[r] * a[3] + sh[3]);
                    ((u32x2*)(hout + (size_t)(row + r) * DM) + lane)[64 * j] = o; } }
        }
        asm volatile("s_waitcnt vmcnt(0)" ::: "memory");
        const int r16 = lane & 15, fq = lane >> 4;
        const int myrow = blk * 128 + F.wave * 16 + r16;
        f32x4 acc0 = {0.f, 0.f, 0.f, 0.f}, acc1 = {0.f, 0.f, 0.f, 0.f}, acc2 = {0.f, 0.f, 0.f, 0.f};
        {
            LAS bf16x8* wl = (LAS bf16x8*)F.lds;
            const bf16x8* hb = (const bf16x8*)(hout + (size_t)myrow * DM + 8 * fq);
#pragma unroll 1
            for (int half = 0; half < 2; ++half) {
                __syncthreads();
#pragma unroll 4
                for (int c = tid_; c < 48 * 128; c += 512) { const int j = c >> 7, kc = c & 127, sst = kc >> 2, fqq = kc & 3;
                    wl[(sst * 3 + (j >> 4)) * 64 + fqq * 16 + (j & 15)] = *(const bf16x8*)(WrT + (size_t)j * DM + half * 1024 + 8 * kc); }
                __syncthreads();
#pragma unroll 16
                for (int s = 0; s < 32; ++s) { const bf16x8 bv = hb[4 * (32 * half + s)];
                    acc0 = __builtin_amdgcn_mfma_f32_16x16x32_bf16(wl[(s * 3 + 0) * 64 + lane], bv, acc0, 0, 0, 0);
                    acc1 = __builtin_amdgcn_mfma_f32_16x16x32_bf16(wl[(s * 3 + 1) * 64 + lane], bv, acc1, 0, 0, 0);
                    acc2 = __builtin_amdgcn_mfma_f32_16x16x32_bf16(wl[(s * 3 + 2) * 64 + lane], bv, acc2, 0, 0, 0); }
            }
        }
        int e0 = 0, e1 = 0, lp0 = 0, lp1 = 0; float w0 = 0.f, w1 = 0.f; bool owner = false;
        {
            float gl[4];
#pragma unroll
            for (int q = 0; q < 4; ++q) gl[q] = acc2[q] + b_group[q];
            int gi = 0; float gm = gl[0];
#pragma unroll
            for (int q = 1; q < 4; ++q) if (gl[q] > gm) { gm = gl[q]; gi = q; }
            float den = 0.f;
#pragma unroll
            for (int q = 0; q < 4; ++q) den += __expf(gl[q] - gm);
            const float pg = 1.f / den;
            owner = (gi == fq);
            float ev[8];
#pragma unroll
            for (int q = 0; q < 4; ++q) { ev[q] = acc0[q] + b_route[8 * fq + q]; ev[4 + q] = acc1[q] + b_route[8 * fq + 4 + q]; }
            int i0 = 0; float v0 = ev[0];
#pragma unroll
            for (int q = 1; q < 8; ++q) if (ev[q] > v0) { v0 = ev[q]; i0 = q; }
            int i1 = -1; float v1 = -3.0e38f;
#pragma unroll
            for (int q = 0; q < 8; ++q) if (q != i0 && ev[q] > v1) { v1 = ev[q]; i1 = q; }
            const float e1x = __expf(v1 - v0); w0 = pg / (1.f + e1x); w1 = pg * e1x / (1.f + e1x);
            e0 = fq * 8 + i0; e1 = fq * 8 + i1;
        }
        __syncthreads();
        if (owner) { lp0 = (int)__hip_atomic_fetch_add((LAS unsigned*)(lcnt + e0), 1u, __ATOMIC_RELAXED, __HIP_MEMORY_SCOPE_WORKGROUP);
                     lp1 = (int)__hip_atomic_fetch_add((LAS unsigned*)(lcnt + e1), 1u, __ATOMIC_RELAXED, __HIP_MEMORY_SCOPE_WORKGROUP); }
        __syncthreads();
        if (tid_ < 32) { const unsigned n = lcnt[tid_]; unsigned base = 0u; if (n) base = atomicAdd(F.ctl + CW_CNT + (l * 32 + tid_) * 64, n); lcnt[32 + tid_] = base; }
        __syncthreads();
        if (owner) {
            const int p0 = (int)lcnt[32 + e0] + lp0, p1 = (int)lcnt[32 + e1] + lp1;
            list[(size_t)e0 * NT + p0] = myrow; list[(size_t)e1 * NT + p1] = myrow;
            tok[myrow * 8 + 0] = e0; tok[myrow * 8 + 1] = e1; tok[myrow * 8 + 2] = p0; tok[myrow * 8 + 3] = p1;
            tok[myrow * 8 + 4] = __builtin_bit_cast(int, w0); tok[myrow * 8 + 5] = __builtin_bit_cast(int, w1);
        }
        __syncthreads();
    }
}

__global__ void __launch_bounds__(512, 2) fwd_kernel(Args args_unused) {
    extern __shared__ __attribute__((aligned(16))) unsigned char lds_raw[];
    Frame F;
    F.lds = (LAS unsigned char*)lds_raw;
    F.MISC = (volatile LAS unsigned*)(F.lds + MISC_OFF);
    F.tid = threadIdx.x; F.lane = F.tid & 63; F.wave = __builtin_amdgcn_readfirstlane(F.tid >> 6);
    F.G = gridDim.x; { const int bx = blockIdx.x; F.vcu = (F.G % 8 == 0) ? (bx % 8) * (F.G / 8) + bx / 8 : bx; }
    F.gw = F.vcu * 8 + F.wave; F.NGW = F.G * 8;
    { const ArgV a0 = get_args(); F.ctl = (unsigned*)(a0.ws() + WS_CTL); }
    for (int u = F.tid; u < 256; u += 512) F.MISC[u] = 0u;
    __syncthreads();
    int lo, hi; { const ArgV a0 = get_args(); lo = a0.ph_lo(); hi = a0.ph_hi(); }
    XcdBarrier bar; bar.bar = F.ctl + CW_BAR; bar.x = 0; bar.st = nullptr;
    if (hi - lo > 1) bar = xcd_barrier_post(F.ctl + CW_BAR, F.MISC);
#ifndef PH_MASK
#define PH_MASK 0x1ff
#endif
#define PM(j) (((PH_MASK) >> (j)) & 1)
#define IN(k) (lo <= (k) && (k) < hi)
#define SEAM(k) do { if (IN(k) && IN((k) + 1)) xcd_barrier(bar); } while (0)
#define PB(kind) do { if ((kind) == PROBE_KIND && blockIdx.x == PROBE_BLOCK && threadIdx.x == 0) { const unsigned long long t_ = __builtin_amdgcn_s_memrealtime(); F.MISC[200] = (unsigned)t_; F.MISC[201] = (unsigned)(t_ >> 32); } } while (0)
#define PE(kind) do { if ((kind) == PROBE_KIND && blockIdx.x == PROBE_BLOCK && threadIdx.x == 0) { const unsigned long long t_ = __builtin_amdgcn_s_memrealtime() - (((unsigned long long)F.MISC[201] << 32) | F.MISC[200]); \
        const unsigned long long a_ = (((unsigned long long)F.MISC[203] << 32) | F.MISC[202]) + t_; F.MISC[202] = (unsigned)a_; F.MISC[203] = (unsigned)(a_ >> 32); } } while (0)
    PB(0); if (PM(0) && IN(0)) { const ArgV args = get_args(); phase_modpart(F, args.in(1), args.in(2), (float*)(args.ws() + WS_MODPART)); } SEAM(0); PE(0);
    PB(1); if (PM(0) && IN(1)) { const ArgV args = get_args(); phase_prep(F, args); } SEAM(1); PE(1);
    for (int l = 0; l < NL; ++l) {
        const int pb = 2 + 7 * l;
        PB(2); if (PM(1) && IN(pb + 0)) { const ArgV args = get_args(); if (l == 0) phase_norm1<0>(F, args, l); else phase_norm1<1>(F, args, l); } SEAM(pb + 0); PE(2);
        PB(3); if (PM(2) && IN(pb + 1)) {
            const ArgV args = get_args();
            DenseSched S; S.init(NT, DIN, DM, (const bf16_t*)(args.ws() + WS_WINT) + (size_t)l * DIN * DM, F.G, (int)blockIdx.x);
            EpiProj E{(bf16_t*)(args.ws() + WS_PROJ), (float*)(args.ws() + WS_KSQ)};
            pg8::gemm_phase<EpiProj, DenseSched>(F.lds, (const bf16_t*)args.out(), DM, S, E);
        } SEAM(pb + 1); PE(3);
        PB(4); if (IN(pb + 2)) { PB(10); if (PM(3)) { const ArgV args = get_args(); phase_gmlp(F, args, l); } PE(10); PB(11); if (PM(4)) { const ArgV args = get_args(); phase_attn(F, args, l); } PE(11); } SEAM(pb + 2); PE(4);
        PB(5); if (PM(7) && IN(pb + 3)) {
            const ArgV args = get_args();
            DenseSched S; S.init(NT, DM, DMIX, (const bf16_t*)(args.ws() + WS_WOUTT) + (size_t)l * DM * DMIX, F.G, (int)blockIdx.x);
            EpiOut E{(bf16_t*)(args.ws() + WS_XB), (const float*)(args.ws() + WS_MODV) + ((size_t)(l * NB) * 6 + 2) * DM};
            pg8::gemm_phase<EpiOut, DenseSched>(F.lds, (const bf16_t*)(args.ws() + WS_YMIX), DMIX, S, E);
        } SEAM(pb + 3); PE(5);
        PB(6); if (PM(5) && IN(pb + 4)) { const ArgV args = get_args(); phase_router(F, args, l); } SEAM(pb + 4); PE(6);
        PB(7); if (PM(6) && IN(pb + 5)) {
            const ArgV args = get_args();
            build_tiles(F, l);
            MoeSched<true> S; S.tp = F.MISC + 16; S.cnt = F.MISC + 64; S.te = (const volatile LAS unsigned*)(F.lds + TILE_E_OFF); S.list = (const int*)(args.ws() + WS_LIST);
            S.Bt = (const bf16_t*)(args.ws() + WS_WGUT) + (size_t)l * NE * 512 * DM; S.bstride_e = (size_t)512 * DM; S.K = DM; S.npn = 2; S.lognpn = 1; S.G = F.G; S.c = F.vcu;
            EpiAct E{(bf16_t*)(args.ws() + WS_ACT)};
            pg8::gemm_phase<EpiAct, MoeSched<true> >(F.lds, (const bf16_t*)args.out(), DM, S, E);
        } SEAM(pb + 5); PE(7);
        PB(8); if (PM(8) && IN(pb + 6)) {
            const ArgV args = get_args();
            build_tiles(F, l);
            MoeSched<false> S; S.tp = F.MISC + 16; S.cnt = F.MISC + 64; S.te = (const volatile LAS unsigned*)(F.lds + TILE_E_OFF); S.list = nullptr;
            S.Bt = (const bf16_t*)(args.ws() + WS_WDT) + (size_t)l * NE * DM * DE; S.bstride_e = (size_t)DM * DE; S.K = DE; S.npn = 8; S.lognpn = 3; S.G = F.G; S.c = F.vcu;
            EpiY E{(unsigned char*)(args.ws() + WS_YSLOT)};
            pg8::gemm_phase<EpiY, MoeSched<false> >(F.lds, (const bf16_t*)(args.ws() + WS_ACT), DE, S, E);
        } SEAM(pb + 6); PE(8);
    }
    PB(9); if (PM(1) && IN(30)) { const ArgV args = get_args(); phase_norm1<2>(F, args, NL); } PE(9);
    if (PROBE_KIND == 20 && blockIdx.x == 128 && threadIdx.x == 0) { const unsigned long long ticks = 1000ull * F.MISC[204];
        const unsigned long long t0 = __builtin_amdgcn_s_memrealtime(); while (__builtin_amdgcn_s_memrealtime() - t0 < ticks) __builtin_amdgcn_s_sleep(20); }
    if (PROBE_KIND >= 0 && PROBE_KIND != 20 && blockIdx.x == PROBE_BLOCK && threadIdx.x == 0) { const unsigned long long pacc = (((unsigned long long)F.MISC[203] << 32) | F.MISC[202]);
        const unsigned long long t0 = __builtin_amdgcn_s_memrealtime(); while (__builtin_amdgcn_s_memrealtime() - t0 < 4ull * pacc) __builtin_amdgcn_s_sleep(20); }
#undef IN
#undef SEAM
}

extern "C" void kernel_launch(void* const* d_in, const int* in_sizes, int n_in, void* d_out, int out_size, void* d_ws, size_t ws_size, hipStream_t stream) {
    static int grid = 0;
    if (grid == 0) {
        if (n_in != 22 || out_size != NT * DM || ws_size < WS_END) { fprintf(stderr, "kernel_launch: unexpected problem (n_in %d out %d ws %zu)\n", n_in, out_size, ws_size); grid = -1; return; }
        int dev = 0, cus = 0;
        if (hipGetDevice(&dev) != hipSuccess || hipDeviceGetAttribute(&cus, hipDeviceAttributeMultiprocessorCount, dev) != hipSuccess) { grid = -1; return; }
        if (hipFuncSetAttribute((const void*)fwd_kernel, hipFuncAttributeMaxDynamicSharedMemorySize, LDS_BYTES) != hipSuccess) { fprintf(stderr, "kernel_launch: hipFuncSetAttribute failed\n"); grid = -1; return; }
        int per_cu = 0;
        (void)hipOccupancyMaxActiveBlocksPerMultiprocessor(&per_cu, (const void*)fwd_kernel, 512, LDS_BYTES);
        (void)hipGetLastError();
        grid = cus;
    }
    if (grid < 0) return;
    (void)hipMemsetAsync((char*)d_ws + WS_CTL, 0, CTL_ZERO_BYTES, stream);
    Args a{};
    for (int i = 0; i < 22; ++i) a.in[i] = (const float*)d_in[i];
    a.out = (float*)d_out; a.ws = (unsigned char*)d_ws;
#if MK_ONE_LAUNCH
    a.ph_lo = 0; a.ph_hi = NPHASE;
    hipLaunchKernelGGL(fwd_kernel, dim3(grid), dim3(512), LDS_BYTES, stream, a);
#else
    for (int p = 0; p < NPHASE; ++p) { a.ph_lo = p; a.ph_hi = p + 1; hipLaunchKernelGGL(fwd_kernel, dim3(grid), dim3(512), LDS_BYTES, stream, a); }
#endif
}
```
